# Optimizing an MI355X kernel written in HIP

```python
import math
import jax, jax.numpy as jnp
from jax import lax
import numpy as np

D_MODEL = 1024
BATCH = 8
SEQ = 4096
DEPTH = 2

N_MEM = 256
N_MIXERS = 2
D_MIX = D_MODEL
XA_HEADS = 4
XA_HEAD_DIM = D_MODEL // 16
D_XA = XA_HEADS * XA_HEAD_DIM
D_TOK = D_MIX - D_XA
CONV_WIDTH = 3
ML_HEADS = 4
ML_HEAD_DIM = D_TOK // ML_HEADS
ML_CHUNK = 64
QK_CONV_WIDTH = 4
D_FF = 256 * int(math.ceil(8 * D_MODEL / 3 / 256))
LN_EPS = 1e-5
DEEPNORM_ALPHA = (2.0 * DEPTH) ** 0.25
DEEPNORM_BETA = (8.0 * DEPTH) ** -0.25
N_CONV_LAYERS = (DEPTH + 1) // 2
N_MLSTM_LAYERS = DEPTH // 2
D_IN_CONV = 3 * D_TOK + D_XA
D_IN_MLSTM = 4 * D_TOK + 2 * ML_HEADS + D_XA

kernel_name = "hybrid_shortconv_mlstm_memxattn_macaron_deepnorm"


def layer_norm(x, g, b):
    xf = x.astype(jnp.float32)
    mu = jnp.mean(xf, -1, keepdims=True)
    var = jnp.mean(jnp.square(xf - mu), -1, keepdims=True)
    y = (xf - mu) * lax.rsqrt(var + LN_EPS)
    return (y * g.astype(jnp.float32) + b.astype(jnp.float32)).astype(x.dtype)


def swiglu(x, w_gate, w_up, w_down):
    return (jax.nn.silu(x @ w_gate) * (x @ w_up)) @ w_down


def causal_dwconv(u, w):
    width = w.shape[0]
    s = u.shape[1]
    up = jnp.pad(u, ((0, 0), (width - 1, 0), (0, 0)))
    out = up[:, width - 1:width - 1 + s] * w[width - 1]
    for j in range(width - 1):
        out = out + up[:, j:j + s] * w[j]
    return out


def memory_cross_attention(q, mem_kv):
    b, s, _ = q.shape
    q = q.reshape(b, s, XA_HEADS, XA_HEAD_DIM)
    k, v = jnp.split(mem_kv, 2, -1)
    k = k.reshape(b, N_MEM, XA_HEADS, XA_HEAD_DIM)
    v = v.reshape(b, N_MEM, XA_HEADS, XA_HEAD_DIM)
    scores = jnp.einsum('bshd,bmhd->bhsm', q, k).astype(jnp.float32) * (XA_HEAD_DIM ** -0.5)
    p = jax.nn.softmax(scores, -1).astype(v.dtype)
    o = jnp.einsum('bhsm,bmhd->bshd', p, v)
    return o.reshape(b, s, D_XA)


def short_conv_mixer(u, conv_w):
    b_gate, c_gate, x_in = jnp.split(u, 3, -1)
    return b_gate * causal_dwconv(c_gate * x_in, conv_w)


def mlstm_chunkwise(q, k, v, log_i, log_f):
    b, s, _ = q.shape
    h_, dh, L = ML_HEADS, ML_HEAD_DIM, ML_CHUNK
    nc = s // L

    def to_chunks(t):
        return t.astype(jnp.float32).reshape(b, nc, L, h_, dh).transpose(1, 0, 3, 2, 4)

    def gate_chunks(g):
        return g.astype(jnp.float32).reshape(b, nc, L, h_).transpose(1, 0, 3, 2)

    qc, kc, vc = to_chunks(q), to_chunks(k) * (dh ** -0.5), to_chunks(v)
    ic, fc = gate_chunks(log_i), gate_chunks(log_f)
    causal = jnp.tril(jnp.ones((L, L), dtype=bool))

    def step(carry, xs):
        c_st, n_st, m_st = carry
        q_, k_, v_, li, lf = xs
        bcum = jnp.cumsum(lf, -1)
        log_d = bcum[..., :, None] - bcum[..., None, :] + li[..., None, :]
        log_d = jnp.where(causal, log_d, -jnp.inf)
        log_inter = bcum + m_st[..., None]
        m_t = jnp.maximum(log_inter, jnp.max(log_d, -1))
        w_intra = jnp.exp(log_d - m_t[..., None])
        w_inter = jnp.exp(log_inter - m_t)
        sc = jnp.einsum('bhtd,bhsd->bhts', q_, k_) * w_intra
        num = (jnp.einsum('bhts,bhse->bhte', sc, v_)
               + w_inter[..., None] * jnp.einsum('bhtd,bhde->bhte', q_, c_st))
        den = jnp.sum(sc, -1) + w_inter * jnp.einsum('bhtd,bhd->bht', q_, n_st)
        h = num / jnp.maximum(jnp.abs(den), jnp.exp(-m_t))[..., None]
        b_last = bcum[..., -1]
        log_w = b_last[..., None] - bcum + li
        m_new = jnp.maximum(b_last + m_st, jnp.max(log_w, -1))
        w_k = jnp.exp(log_w - m_new[..., None])
        decay = jnp.exp(b_last + m_st - m_new)
        c_new = decay[..., None, None] * c_st + jnp.einsum('bhs,bhsd,bhse->bhde', w_k, k_, v_)
        n_new = decay[..., None] * n_st + jnp.einsum('bhs,bhsd->bhd', w_k, k_)
        return (c_new, n_new, m_new), h

    init = (jnp.zeros((b, h_, dh, dh), jnp.float32),
            jnp.zeros((b, h_, dh), jnp.float32),
            jnp.zeros((b, h_), jnp.float32))
    _, hs = lax.scan(step, init, (qc, kc, vc, ic, fc))
    return hs.transpose(1, 0, 3, 2, 4).reshape(b, s, h_, dh)


def mlstm_mixer(u, b_gates, qk_conv_w, head_norm_g):
    b, s, _ = u.shape
    qk, v, o_pre, gates = jnp.split(u, [2 * D_TOK, 3 * D_TOK, 4 * D_TOK], -1)
    qk = jax.nn.silu(causal_dwconv(qk, qk_conv_w))
    q, k = jnp.split(qk, 2, -1)
    gates = gates.astype(jnp.float32) + b_gates.astype(jnp.float32)
    log_i = gates[..., :ML_HEADS]
    log_f = jax.nn.log_sigmoid(gates[..., ML_HEADS:])
    h = mlstm_chunkwise(q, k, v, log_i, log_f)
    mu = jnp.mean(h, -1, keepdims=True)
    var = jnp.mean(jnp.square(h - mu), -1, keepdims=True)
    h = (h - mu) * lax.rsqrt(var + LN_EPS) * head_norm_g.astype(jnp.float32)
    return jax.nn.sigmoid(o_pre) * h.reshape(b, s, D_TOK).astype(u.dtype)


def setup_inputs(seed: int = 0) -> dict:
    key = jax.random.key(seed)
    ks = jax.random.split(key, 20)
    nrm = jax.random.normal
    f32 = jnp.float32
    x = nrm(ks[0], (BATCH, SEQ, D_MODEL), f32)
    mem = nrm(ks[1], (BATCH, N_MEM, D_MODEL), f32)
    ln_g = 1.0 + 0.02 * nrm(ks[2], (DEPTH, 3, D_MODEL), f32)
    ln_b = 0.02 * nrm(ks[3], (DEPTH, 3, D_MODEL), f32)
    ffn_w_gate = nrm(ks[4], (DEPTH, 2, D_MODEL, D_FF), f32) * D_MODEL ** -0.5
    ffn_w_up = nrm(ks[5], (DEPTH, 2, D_MODEL, D_FF), f32) * D_MODEL ** -0.5
    ffn_w_down = nrm(ks[6], (DEPTH, 2, D_FF, D_MODEL), f32) * (D_FF ** -0.5 * DEEPNORM_BETA)
    w_kv_mem = nrm(ks[7], (DEPTH, D_MODEL, 2 * D_XA), f32) * D_MODEL ** -0.5
    w_out = nrm(ks[8], (DEPTH, D_MIX, D_MODEL), f32) * (D_MIX ** -0.5 * DEEPNORM_BETA)
    w_in_conv = nrm(ks[9], (N_CONV_LAYERS, D_MODEL, D_IN_CONV), f32) * D_MODEL ** -0.5
    conv_w = nrm(ks[10], (N_CONV_LAYERS, CONV_WIDTH, D_TOK), f32) * CONV_WIDTH ** -0.5
    w_in_mlstm = nrm(ks[11], (N_MLSTM_LAYERS, D_MODEL, D_IN_MLSTM), f32) * D_MODEL ** -0.5
    w_in_mlstm = w_in_mlstm.at[:, :, 4 * D_TOK:4 * D_TOK + 2 * ML_HEADS].multiply(0.1)
    b_i = 0.1 * nrm(ks[12], (N_MLSTM_LAYERS, ML_HEADS), f32)
    b_f = jnp.linspace(3.0, 6.0, ML_HEADS, dtype=f32) + 0.1 * nrm(ks[13], (N_MLSTM_LAYERS, ML_HEADS), f32)
    b_gates = jnp.concatenate([b_i, b_f], -1)
    qk_conv_w = nrm(ks[14], (N_MLSTM_LAYERS, QK_CONV_WIDTH, 2 * D_TOK), f32) * QK_CONV_WIDTH ** -0.5
    head_norm_g = 1.0 + 0.02 * nrm(ks[15], (N_MLSTM_LAYERS, ML_HEADS, ML_HEAD_DIM), f32)
    return {"x": x, "mem": mem, "ln_g": ln_g, "ln_b": ln_b,
            "ffn_w_gate": ffn_w_gate, "ffn_w_up": ffn_w_up, "ffn_w_down": ffn_w_down,
            "w_kv_mem": w_kv_mem, "w_out": w_out,
            "w_in_conv": w_in_conv, "conv_w": conv_w,
            "w_in_mlstm": w_in_mlstm, "b_gates": b_gates,
            "qk_conv_w": qk_conv_w, "head_norm_g": head_norm_g}


def reference(x, mem, ln_g, ln_b, ffn_w_gate, ffn_w_up, ffn_w_down, w_kv_mem, w_out,
              w_in_conv, conv_w, w_in_mlstm, b_gates, qk_conv_w, head_norm_g):
    alpha = DEEPNORM_ALPHA
    for l in range(DEPTH):
        x = layer_norm(alpha * x + 0.5 * swiglu(x, ffn_w_gate[l, 0], ffn_w_up[l, 0], ffn_w_down[l, 0]),
                       ln_g[l, 0], ln_b[l, 0])
        mem_kv = mem @ w_kv_mem[l]
        j = l // N_MIXERS
        if l % N_MIXERS == 0:
            u = x @ w_in_conv[j]
            tok = short_conv_mixer(u[..., :3 * D_TOK], conv_w[j])
        else:
            u = x @ w_in_mlstm[j]
            tok = mlstm_mixer(u[..., :4 * D_TOK + 2 * ML_HEADS], b_gates[j], qk_conv_w[j], head_norm_g[j])
        xa = memory_cross_attention(u[..., -D_XA:], mem_kv)
        mix = jnp.concatenate([tok, xa], -1) @ w_out[l]
        x = layer_norm(alpha * x + mix, ln_g[l, 1], ln_b[l, 1])
        x = layer_norm(alpha * x + 0.5 * swiglu(x, ffn_w_gate[l, 1], ffn_w_up[l, 1], ffn_w_down[l, 1]),
                       ln_g[l, 2], ln_b[l, 2])
    return x
```

```cpp
#include <hip/hip_runtime.h>
#include <hip/hip_cooperative_groups.h>
#include <cstdio>
#include <cstdint>
namespace cg = cooperative_groups;
namespace pg8 {
#define PG8_LAS __attribute__((address_space(3)))
typedef unsigned short bf16_t;
typedef short bf16x8 __attribute__((ext_vector_type(8)));
typedef float f32x4 __attribute__((ext_vector_type(4)));
typedef unsigned u32x4 __attribute__((ext_vector_type(4)));
constexpr int BM = 256, BK = 64, HALF = 128, HTB = HALF * BK * 2  , STAGE_BYTES = 8 * HTB, NXCD = 8, WGM = 8;

__host__ __device__ __forceinline__ int lds_byte(int r, int c) { const int st = (r >> 4) * 2 + (c >> 5), rr = r & 15, cc = c & 31, ob = rr * 64 + cc * 2; return st * 1024 + (ob ^ (((ob >> 9) & 1) << 5)); }
__host__ __device__ __forceinline__ void stage_rc(int b, int& R, int& C) { const int st = b / 1024, sb = b % 1024, swz = sb ^ (((sb >> 9) & 1) << 5); R = (st >> 1) * 16 + swz / 64; C = (st & 1) * 32 + (swz % 64) / 2; }
__host__ __device__ __forceinline__ int perm32(int rho) { const int n = rho >> 4, i = rho & 15; return 8 * (i >> 2) + 4 * n + (i & 3); }

struct Unit { int pm, pn; };
struct Gemm { const bf16_t* A; const bf16_t* Bt; int M, N, K; };

struct StaticOrder {
    int nM, nN, nwg, G, c;
    __host__ __device__ void init(int M, int N, int G_, int c_) { nM = M / BM; nN = N / BM; nwg = nM * nN; G = G_; c = c_; }
    __host__ __device__ bool next(int i, Unit& u) const {
        const long L = (long)i * G + c; if (L >= nwg) return false;
        int wgid = (int)L; { const int q = nwg / NXCD, r = nwg % NXCD, xcd = wgid % NXCD, off = wgid / NXCD; wgid = (xcd < r ? xcd * (q + 1) : r * (q + 1) + (xcd - r) * q) + off; }
        const int nig = WGM * nN, gid = wgid / nig, fm = gid * WGM, gsz = (nM - fm) < WGM ? (nM - fm) : WGM;
        u.pm = fm + ((wgid % nig) % gsz); u.pn = (wgid % nig) / gsz; return true;
    }
    __device__ __forceinline__ void a_ready(const Unit&) const {}
    __device__ __forceinline__ void done(const Unit&) const {}
};
__device__ __forceinline__ unsigned cvt_pk_bf16(float lo, float hi) { unsigned r; asm volatile("v_cvt_pk_bf16_f32 %0, %1, %2" : "=v"(r) : "v"(lo), "v"(hi)); return r; }
typedef float f32x2 __attribute__((ext_vector_type(2)));
template <class Epi, class Sched, bool ALIGN_EPI = false, bool SP2 = false>
__device__ __forceinline__ void gemm_phase(PG8_LAS unsigned char* lds, const Gemm g, const Sched& S, const Epi& E) {
    int tid_ = threadIdx.x; asm volatile("" : "+v"(tid_));
    const int tid = tid_, wid = __builtin_amdgcn_readfirstlane(tid >> 6), lane = tid & 63, wr = wid >> 2, wc = wid & 3, fr = lane & 15, fq = lane >> 4;
    const int K = g.K, nt = K / BK;
    unsigned voffA[2], voffB[2];
#pragma unroll
    for (int i = 0; i < 2; ++i) { int R, C; stage_rc(tid * 16 + i * 8192, R, C); const int Rb = Epi::PERM ? ((R & ~31) + perm32(R & 31)) : R;
        voffA[i] = (unsigned)(R * K + C) * 2u; voffB[i] = (unsigned)(Rb * K + C) * 2u; }
    const size_t kstep = (size_t)(BK * 2);
    const size_t hstep = (size_t)HALF * K * 2;
    const size_t tstep = 2 * hstep;
    const unsigned ldsw = (unsigned)wid * 1024u;
    const int aoff = lds_byte(wr * 64 + fr, fq * 8), boff = lds_byte(wc * 32 + fr, fq * 8);
#define PG8_SA(b, h) (((b) * 2 + (h)) * HTB)
#define PG8_SB(b, h) ((4 + (b) * 2 + (h)) * HTB)
#define PG8_STAGE(bufoff, gbase, voff) do { _Pragma("unroll") for (int _i = 0; _i < 2; ++_i) \
        __builtin_amdgcn_global_load_lds((const unsigned*)((const char*)(gbase) + (voff)[_i]), (PG8_LAS unsigned*)(lds + (bufoff) + ldsw + _i * 8192), 16, 0, 0); } while (0)
#define PG8_LDA(dst, b, h) do { _Pragma("unroll") for (int m = 0; m < 4; ++m) _Pragma("unroll") for (int k = 0; k < 2; ++k) dst[m][k] = *(const PG8_LAS bf16x8*)(lds + PG8_SA(b, h) + aoff + m * 2048 + k * 1024); } while (0)
#define PG8_LDB(dst, b, h) do { _Pragma("unroll") for (int n = 0; n < 2; ++n) _Pragma("unroll") for (int k = 0; k < 2; ++k) dst[n][k] = *(const PG8_LAS bf16x8*)(lds + PG8_SB(b, h) + boff + n * 2048 + k * 1024); } while (0)
#define PG8_MMA(ai, bj, At, Bt) do { __builtin_amdgcn_s_setprio(1); _Pragma("unroll") for (int m = 0; m < 4; ++m) _Pragma("unroll") for (int n = 0; n < 2; ++n) _Pragma("unroll") for (int k = 0; k < 2; ++k) \
        acc[ai][bj][m][n] = __builtin_amdgcn_mfma_f32_16x16x32_bf16(Bt[n][k], At[m][k], acc[ai][bj][m][n], 0, 0, 0); __builtin_amdgcn_s_setprio(0); } while (0)
#define PG8_WAIT_V(n) asm volatile("s_waitcnt vmcnt(" #n ")" ::: "memory")
#define PG8_WAIT_L(n) asm volatile("s_waitcnt lgkmcnt(" #n ")" ::: "memory")
#define PG8_BAR __builtin_amdgcn_s_barrier()
#define PG8_SCHED __builtin_amdgcn_sched_barrier(0)
    Unit cur, nxt; int ui = 0;
    if (!S.next(0, cur)) return;
    f32x4 acc[2][2][4][2];
#pragma unroll
    for (int a = 0; a < 2; ++a)
#pragma unroll
        for (int b = 0; b < 2; ++b)
#pragma unroll
            for (int m = 0; m < 4; ++m)
#pragma unroll
                for (int n = 0; n < 2; ++n) acc[a][b][m][n] = (f32x4){0.f, 0.f, 0.f, 0.f};
    bf16x8 At[4][2], B0[2][2], B1[2][2];
    const char* cA = (const char*)g.A + (size_t)cur.pm * tstep; const char* cB = (const char*)g.Bt + (size_t)cur.pn * tstep;
    S.a_ready(cur);
    if constexpr (SP2) {
        PG8_STAGE(PG8_SB(0, 0), cB, voffB); PG8_STAGE(PG8_SB(0, 1), cB + hstep, voffB); PG8_STAGE(PG8_SA(0, 0), cA, voffA); PG8_STAGE(PG8_SA(0, 1), cA + hstep, voffA);
        if (wr == 1) PG8_BAR;
        PG8_WAIT_V(2); PG8_BAR;
        PG8_STAGE(PG8_SB(1, 0), cB + kstep, voffB); PG8_STAGE(PG8_SA(1, 0), cA + kstep, voffA); PG8_STAGE(PG8_SB(1, 1), cB + hstep + kstep, voffB);
        PG8_WAIT_V(6); PG8_BAR;
    } else {
        PG8_STAGE(PG8_SB(0, 0), cB, voffB); PG8_STAGE(PG8_SA(0, 0), cA, voffA); PG8_STAGE(PG8_SB(0, 1), cB + hstep, voffB); PG8_STAGE(PG8_SA(0, 1), cA + hstep, voffA);
        if (wr == 1) PG8_BAR;
        PG8_WAIT_V(4); PG8_BAR;
        PG8_STAGE(PG8_SB(1, 0), cB + kstep, voffB); PG8_STAGE(PG8_SA(1, 0), cA + kstep, voffA); PG8_STAGE(PG8_SB(1, 1), cB + hstep + kstep, voffB);
        PG8_WAIT_V(6); PG8_BAR;
    }
    for (;;) {
        const bool has_next = S.next(ui + 1, nxt);
        const char* nA = has_next ? (const char*)g.A + (size_t)nxt.pm * tstep : cA; const char* nB = has_next ? (const char*)g.Bt + (size_t)nxt.pn * tstep : cB;
        for (int t = 0; t < nt; t += 2) {
            const bool last = (t == nt - 2);
            const char* a1 = cA + (size_t)(t + 1) * kstep;
            const char* a2 = last ? nA : cA + (size_t)(t + 2) * kstep; const char* b2 = last ? nB : cB + (size_t)(t + 2) * kstep;
            const char* a3 = a2 + kstep; const char* b3 = b2 + kstep;
            if (last && has_next) S.a_ready(nxt);
            if constexpr (SP2) {
            PG8_LDB(B0, 0, 0); PG8_LDB(B1, 0, 1); PG8_SCHED; PG8_LDA(At, 0, 0); PG8_STAGE(PG8_SA(1, 1), a1 + hstep, voffA);
            PG8_WAIT_V(8); PG8_WAIT_L(0); PG8_BAR; PG8_MMA(0, 0, At, B0); PG8_MMA(0, 1, At, B1); PG8_BAR; PG8_SCHED;
            PG8_LDA(At, 0, 1); PG8_STAGE(PG8_SB(0, 0), b2, voffB); PG8_STAGE(PG8_SB(0, 1), b2 + hstep, voffB); PG8_STAGE(PG8_SA(0, 0), a2, voffA);
            PG8_WAIT_V(8); PG8_WAIT_L(0); PG8_BAR; PG8_MMA(1, 0, At, B0); PG8_MMA(1, 1, At, B1); PG8_BAR; PG8_SCHED;
            PG8_LDB(B0, 1, 0); PG8_LDB(B1, 1, 1); PG8_SCHED; PG8_LDA(At, 1, 0); PG8_STAGE(PG8_SA(0, 1), a2 + hstep, voffA);
            PG8_WAIT_V(8); PG8_WAIT_L(0); PG8_BAR; PG8_MMA(0, 0, At, B0); PG8_MMA(0, 1, At, B1); PG8_BAR; PG8_SCHED;
            PG8_LDA(At, 1, 1); PG8_STAGE(PG8_SB(1, 0), b3, voffB); PG8_STAGE(PG8_SB(1, 1), b3 + hstep, voffB); PG8_STAGE(PG8_SA(1, 0), a3, voffA);
            PG8_WAIT_V(8); PG8_WAIT_L(0); PG8_BAR; PG8_MMA(1, 0, At, B0); PG8_MMA(1, 1, At, B1); PG8_BAR; PG8_SCHED;
            } else {
            PG8_LDB(B0, 0, 0); PG8_SCHED; PG8_LDA(At, 0, 0); PG8_STAGE(PG8_SA(1, 1), a1 + hstep, voffA);
            PG8_WAIT_L(8); PG8_BAR; PG8_WAIT_L(0); PG8_MMA(0, 0, At, B0); PG8_BAR; PG8_SCHED;
            PG8_LDB(B1, 0, 1); PG8_STAGE(PG8_SB(0, 0), b2, voffB);
            PG8_BAR; PG8_WAIT_L(0); PG8_MMA(0, 1, At, B1); PG8_BAR;
            PG8_LDA(At, 0, 1); PG8_STAGE(PG8_SA(0, 0), a2, voffA);
            PG8_BAR; PG8_WAIT_L(0); PG8_MMA(1, 0, At, B0); PG8_BAR; PG8_SCHED;
            PG8_STAGE(PG8_SB(0, 1), b2 + hstep, voffB);
            PG8_WAIT_V(6); PG8_BAR; PG8_MMA(1, 1, At, B1); PG8_BAR;
            PG8_LDB(B0, 1, 0); PG8_SCHED; PG8_LDA(At, 1, 0); PG8_STAGE(PG8_SA(0, 1), a2 + hstep, voffA);
            PG8_WAIT_L(8); PG8_BAR; PG8_WAIT_L(0); PG8_MMA(0, 0, At, B0); PG8_BAR; PG8_SCHED;
            PG8_LDB(B1, 1, 1); PG8_STAGE(PG8_SB(1, 0), b3, voffB);
            PG8_BAR; PG8_WAIT_L(0); PG8_MMA(0, 1, At, B1); PG8_BAR;
            PG8_LDA(At, 1, 1); PG8_STAGE(PG8_SA(1, 0), a3, voffA);
            PG8_BAR; PG8_WAIT_L(0); PG8_MMA(1, 0, At, B0); PG8_BAR; PG8_SCHED;
            PG8_STAGE(PG8_SB(1, 1), b3 + hstep, voffB);
            PG8_WAIT_V(6); PG8_BAR; PG8_MMA(1, 1, At, B1); PG8_BAR;
            }
        }
        if constexpr (ALIGN_EPI) { if (wr == 0) PG8_BAR; }
        if constexpr (!Epi::AFTER_DRAIN) { E(acc, cur, wr, wc, fr, fq); S.done(cur); }
        if (!has_next) break;
#pragma unroll
        for (int a = 0; a < 2; ++a)
#pragma unroll
            for (int b = 0; b < 2; ++b)
#pragma unroll
                for (int m = 0; m < 4; ++m)
#pragma unroll
                    for (int n = 0; n < 2; ++n) acc[a][b][m][n] = (f32x4){0.f, 0.f, 0.f, 0.f};
        cur = nxt; cA = nA; cB = nB; ++ui;
        if constexpr (ALIGN_EPI) { if (wr == 1) PG8_BAR; }
    }
    PG8_WAIT_V(0);
    if constexpr (!ALIGN_EPI) { if (wr == 0) PG8_BAR; }
    PG8_BAR;
    if constexpr (Epi::AFTER_DRAIN) { E.fused(acc, cur, wr, wc, fr, fq, lds, wid, lane); S.done(cur); }
#undef PG8_SA
#undef PG8_SB
#undef PG8_STAGE
#undef PG8_LDA
#undef PG8_LDB
#undef PG8_MMA
#undef PG8_WAIT_V
#undef PG8_WAIT_L
#undef PG8_BAR
#undef PG8_SCHED
}
}

using pg8::bf16_t; using pg8::bf16x8; using pg8::f32x4; using pg8::u32x4; using pg8::Unit;
#define LAS __attribute__((address_space(3)))
typedef unsigned u32x2 __attribute__((ext_vector_type(2)));

constexpr int NTOK = 32768, DM = 1024, FF = 2816, SEQ = 4096;
constexpr int LDU0 = 2560, LDU1 = 3328, NIN1P = 3584, NS1 = 3336;
constexpr float LN_EPS = 1e-5f, ALPHA = 1.41421356237f, RS192 = 0.07216878364870322f;
constexpr int LDS_MAIN = 158720, LDS_BYTES = LDS_MAIN + 16;
#ifndef PG8_SP2
#define PG8_SP2 true
#endif
#ifndef PG8_ALIGN
#define PG8_ALIGN true
#endif
#ifndef DUP_ST
#define DUP_ST (-1)
#endif
#ifndef DUP_L
#define DUP_L (-1)
#endif
#ifndef EXTRA_SYNC
#define EXTRA_SYNC 0
#endif
#ifndef DUP_PRO
#define DUP_PRO 0
#endif
#ifndef DUP_LN
#define DUP_LN 0
#endif

constexpr size_t SZ_WGU = (size_t)5632 * 1024 * 2, SZ_WD = (size_t)1024 * 2816 * 2, SZ_WKV = (size_t)512 * 1024 * 2, SZ_WOUT = (size_t)1024 * 1024 * 2;
constexpr size_t OFF_WGU = 0;
constexpr size_t OFF_WD = OFF_WGU + 4 * SZ_WGU;
constexpr size_t OFF_WKV = OFF_WD + 4 * SZ_WD;
constexpr size_t OFF_WOUT = OFF_WKV + 2 * SZ_WKV;
constexpr size_t OFF_WIN0 = OFF_WOUT + 2 * SZ_WOUT;
constexpr size_t OFF_WIN1 = OFF_WIN0 + (size_t)2560 * 1024 * 2;
constexpr size_t OFF_XB = OFF_WIN1 + (size_t)NIN1P * 1024 * 2;
constexpr size_t OFF_HU = OFF_XB + (size_t)NTOK * 1024 * 2;
constexpr size_t OFF_CBUF = OFF_HU + (size_t)NTOK * LDU1 * 2;
constexpr size_t OFF_MEMB = OFF_CBUF + (size_t)2048 * 36864 * 2;
constexpr size_t OFF_MEMKV = OFF_MEMB + (size_t)2048 * 1024 * 2;
constexpr size_t OFF_GATES = OFF_MEMKV + (size_t)2 * 2048 * 512 * 2;
constexpr size_t OFF_NBUF = OFF_GATES + (size_t)NTOK * 8 * 4;
constexpr size_t OFF_GB = OFF_NBUF + (size_t)2048 * 192 * 4;
constexpr size_t OFF_GLI = OFF_GB + (size_t)32 * 4096 * 4;
constexpr size_t OFF_GM = OFF_GLI + (size_t)32 * 4096 * 4;
constexpr size_t OFF_BAR = OFF_GM + (size_t)5 * 2048 * 4;
constexpr size_t WS_END = OFF_BAR + (size_t)3456 * 4;

struct Params {
    const float *x, *mem, *ln_g, *ln_b, *wg, *wu, *wd, *wkv, *wout, *win0, *convw, *win1, *bgates, *qkconvw, *hng;
    float* out; unsigned char* ws;
};

__device__ __forceinline__ float bf2f(unsigned b) { return __uint_as_float(b << 16); }
__device__ __forceinline__ unsigned f2bf(float f) { unsigned u = __float_as_uint(f); u += 0x7FFFu + ((u >> 16) & 1u); return u >> 16; }
__device__ __forceinline__ unsigned pk2(float lo, float hi) { return f2bf(lo) | (f2bf(hi) << 16); }
__device__ __forceinline__ float silu_f(float v) { return v * __builtin_amdgcn_rcpf(1.0f + __expf(-v)); }
__device__ __forceinline__ float sigmoid_f(float v) { return __builtin_amdgcn_rcpf(1.0f + __expf(-v)); }
__device__ __forceinline__ float wsum(float v) {
#pragma unroll
    for (int o = 1; o < 64; o <<= 1) v += __shfl_xor(v, o);
    return v;
}
__device__ __forceinline__ float wmax(float v) {
#pragma unroll
    for (int o = 1; o < 64; o <<= 1) v = fmaxf(v, __shfl_xor(v, o));
    return v;
}
#define LO16(w) bf2f((w) & 0xffffu)
#define HI16(w) __uint_as_float((w) & 0xffff0000u)
#define MFMA16(a, b, c) __builtin_amdgcn_mfma_f32_16x16x32_bf16((a), (b), (c), 0, 0, 0)

struct EpiSwiglu {
    static constexpr bool PERM = true, AFTER_DRAIN = false;
    bf16_t* H;
    __device__ __forceinline__ void operator()(const f32x4 (&acc)[2][2][4][2], const Unit& u, int wr, int wc, int fr, int fq) const {
        const int row0 = u.pm * 256 + wr * 64 + fr, col0 = u.pn * 128 + wc * 32 + 8 * fq;
#pragma unroll
        for (int ai = 0; ai < 2; ++ai)
#pragma unroll
            for (int m = 0; m < 4; ++m) {
                bf16_t* rowp = H + (size_t)(row0 + ai * 128 + m * 16) * FF + col0;
                const f32x4 g0 = acc[ai][0][m][0], g1 = acc[ai][0][m][1], u0 = acc[ai][1][m][0], u1 = acc[ai][1][m][1];
                u32x4 w;
                w.x = pg8::cvt_pk_bf16(silu_f(g0[0]) * u0[0], silu_f(g0[1]) * u0[1]);
                w.y = pg8::cvt_pk_bf16(silu_f(g0[2]) * u0[2], silu_f(g0[3]) * u0[3]);
                w.z = pg8::cvt_pk_bf16(silu_f(g1[0]) * u1[0], silu_f(g1[1]) * u1[1]);
                w.w = pg8::cvt_pk_bf16(silu_f(g1[2]) * u1[2], silu_f(g1[3]) * u1[3]);
                *(u32x4*)rowp = w;
            }
    }
};
struct EpiRes {
    static constexpr bool PERM = false, AFTER_DRAIN = false;
    const float* res; float* out; float scale;
    __device__ __forceinline__ void operator()(const f32x4 (&acc)[2][2][4][2], const Unit& u, int wr, int wc, int fr, int fq) const {
        const int row0 = u.pm * 256 + wr * 64 + fr, col0 = u.pn * 256 + wc * 32 + 4 * fq;
#pragma unroll
        for (int ai = 0; ai < 2; ++ai)
#pragma unroll
            for (int m = 0; m < 4; ++m) {
                const size_t off = (size_t)(row0 + ai * 128 + m * 16) * DM + col0;
#pragma unroll
                for (int bj = 0; bj < 2; ++bj)
#pragma unroll
                    for (int n = 0; n < 2; ++n) {
                        const f32x4 r = *(const f32x4*)(res + off + bj * 128 + n * 16);
                        *(f32x4*)(out + off + bj * 128 + n * 16) = r * ALPHA + acc[ai][bj][m][n] * scale;
                    }
                asm volatile("" ::: "memory");
            }
    }
};
struct EpiU {
    static constexpr bool PERM = true, AFTER_DRAIN = false;
    bf16_t* O; int ldc; int nstore; float* gates; int gate_pn;
    __device__ __forceinline__ void operator()(const f32x4 (&acc)[2][2][4][2], const Unit& u, int wr, int wc, int fr, int fq) const {
        const int row0 = u.pm * 256 + wr * 64 + fr;
        if (u.pn < nstore) {
            const int col0 = u.pn * 256 + wc * 32 + 8 * fq;
#pragma unroll
            for (int ai = 0; ai < 2; ++ai)
#pragma unroll
                for (int m = 0; m < 4; ++m) {
                    bf16_t* rowp = O + (size_t)(row0 + ai * 128 + m * 16) * ldc + col0;
#pragma unroll
                    for (int bj = 0; bj < 2; ++bj) {
                        const f32x4 v0 = acc[ai][bj][m][0], v1 = acc[ai][bj][m][1];
                        u32x4 w; w.x = pg8::cvt_pk_bf16(v0[0], v0[1]); w.y = pg8::cvt_pk_bf16(v0[2], v0[3]); w.z = pg8::cvt_pk_bf16(v1[0], v1[1]); w.w = pg8::cvt_pk_bf16(v1[2], v1[3]);
                        *(u32x4*)(rowp + bj * 128) = w;
                    }
                }
        } else if (u.pn == gate_pn) {
            if (wc == 0 && fq == 0) {
#pragma unroll
                for (int ai = 0; ai < 2; ++ai)
#pragma unroll
                    for (int m = 0; m < 4; ++m) {
                        float* gp = gates + (size_t)(row0 + ai * 128 + m * 16) * 8;
                        *(f32x4*)gp = acc[ai][0][m][0]; *(f32x4*)(gp + 4) = acc[ai][0][m][1];
                    }
            }
        }
    }
};

struct EpiAll {
    static constexpr bool PERM = true, AFTER_DRAIN = false;
    int mode; bf16_t* O; int ldc; int nstore; float* gates; int gate_pn; const float* res; const bf16_t* resb; float* out; float scale;
    __device__ __forceinline__ void operator()(const f32x4 (&acc)[2][2][4][2], const Unit& u, int wr, int wc, int fr, int fq) const {
        const int row0 = u.pm * 256 + wr * 64 + fr;
        if (mode == 0) {
            const int col0 = u.pn * 128 + wc * 32 + 8 * fq;
#pragma unroll
            for (int ai = 0; ai < 2; ++ai)
#pragma unroll
                for (int m = 0; m < 4; ++m) {
                    bf16_t* rowp = O + (size_t)(row0 + ai * 128 + m * 16) * FF + col0;
                    const f32x4 g0 = acc[ai][0][m][0], g1 = acc[ai][0][m][1], u0 = acc[ai][1][m][0], u1 = acc[ai][1][m][1];
                    u32x4 w;
                    w.x = pg8::cvt_pk_bf16(silu_f(g0[0]) * u0[0], silu_f(g0[1]) * u0[1]);
                    w.y = pg8::cvt_pk_bf16(silu_f(g0[2]) * u0[2], silu_f(g0[3]) * u0[3]);
                    w.z = pg8::cvt_pk_bf16(silu_f(g1[0]) * u1[0], silu_f(g1[1]) * u1[1]);
                    w.w = pg8::cvt_pk_bf16(silu_f(g1[2]) * u1[2], silu_f(g1[3]) * u1[3]);
                    *(u32x4*)rowp = w;
                }
        } else if (mode == 1) {
            const int col0 = u.pn * 256 + wc * 32 + 8 * fq;
#pragma unroll
            for (int ai = 0; ai < 2; ++ai)
#pragma unroll
                for (int m = 0; m < 4; ++m) {
                    const size_t off = (size_t)(row0 + ai * 128 + m * 16) * DM + col0;
#pragma unroll
                    for (int bj = 0; bj < 2; ++bj) {
                        f32x4 r0, r1;
                        if (resb) { const u32x4 rb = *(const u32x4*)(resb + off + bj * 128); r0 = (f32x4){LO16(rb.x), HI16(rb.x), LO16(rb.y), HI16(rb.y)}; r1 = (f32x4){LO16(rb.z), HI16(rb.z), LO16(rb.w), HI16(rb.w)}; }
                        else { r0 = *(const f32x4*)(res + off + bj * 128); r1 = *(const f32x4*)(res + off + bj * 128 + 4); }
                        *(f32x4*)(out + off + bj * 128) = r0 * ALPHA + acc[ai][bj][m][0] * scale;
                        *(f32x4*)(out + off + bj * 128 + 4) = r1 * ALPHA + acc[ai][bj][m][1] * scale;
                    }
                    if (m == 3 && !resb) asm volatile("" ::: "memory");
                }
        } else {
            if (u.pn < nstore) {
                const int col0 = u.pn * 256 + wc * 32 + 8 * fq;
#pragma unroll
                for (int ai = 0; ai < 2; ++ai)
#pragma unroll
                    for (int m = 0; m < 4; ++m) {
                        bf16_t* rowp = O + (size_t)(row0 + ai * 128 + m * 16) * ldc + col0;
#pragma unroll
                        for (int bj = 0; bj < 2; ++bj) {
                            const f32x4 v0 = acc[ai][bj][m][0], v1 = acc[ai][bj][m][1];
                            u32x4 w; w.x = pg8::cvt_pk_bf16(v0[0], v0[1]); w.y = pg8::cvt_pk_bf16(v0[2], v0[3]); w.z = pg8::cvt_pk_bf16(v1[0], v1[1]); w.w = pg8::cvt_pk_bf16(v1[2], v1[3]);
                            *(u32x4*)(rowp + bj * 128) = w;
                        }
                    }
            } else if (u.pn == gate_pn) {
                if (wc == 0 && fq == 0) {
#pragma unroll
                    for (int ai = 0; ai < 2; ++ai)
#pragma unroll
                        for (int m = 0; m < 4; ++m) {
                            float* gp = gates + (size_t)(row0 + ai * 128 + m * 16) * 8;
                            *(f32x4*)gp = acc[ai][0][m][0]; *(f32x4*)(gp + 4) = acc[ai][0][m][1];
                        }
                }
            }
        }
    }
};

__device__ __forceinline__ void tr_item(const float* colp4, int Ns, bf16_t* WT, int K, int r0, int k0, LAS float* scr, int lane) {
    f32x4 v[8];
#pragma unroll
    for (int i = 0; i < 8; ++i) { const int kk = (lane >> 3) + 8 * i; v[i] = colp4 ? *(const f32x4*)(colp4 + (size_t)(k0 + kk) * Ns) : (f32x4){0.f, 0.f, 0.f, 0.f}; }
#pragma unroll
    for (int i = 0; i < 8; ++i) { const int kk = (lane >> 3) + 8 * i; LAS float* d = scr + kk * 33 + 4 * (lane & 7); d[0] = v[i][0]; d[1] = v[i][1]; d[2] = v[i][2]; d[3] = v[i][3]; }
    asm volatile("s_waitcnt lgkmcnt(0)" ::: "memory");
    const int c = lane & 7;
#pragma unroll
    for (int j = 0; j < 4; ++j) { const int n = (lane >> 3) + 8 * j; const LAS float* s = scr + (8 * c) * 33 + n;
        u32x4 o; o.x = pk2(s[0], s[33]); o.y = pk2(s[2 * 33], s[3 * 33]); o.z = pk2(s[4 * 33], s[5 * 33]); o.w = pk2(s[6 * 33], s[7 * 33]);
        *(u32x4*)(WT + (size_t)(r0 + n) * K + k0 + 8 * c) = o; }
    asm volatile("s_waitcnt lgkmcnt(0)" ::: "memory");
}
__device__ __forceinline__ void cvt_rows(const float* src, bf16_t* dst, size_t n8, size_t gtid, size_t nthr) {
    for (size_t i = gtid; i < n8; i += nthr) { const f32x4 a = *(const f32x4*)(src + i * 8), b = *(const f32x4*)(src + i * 8 + 4);
        u32x4 w; w.x = pk2(a[0], a[1]); w.y = pk2(a[2], a[3]); w.z = pk2(b[0], b[1]); w.w = pk2(b[2], b[3]); *(u32x4*)(dst + i * 8) = w; }
}
__device__ __forceinline__ void prologue(const Params& p, LAS unsigned char* lds, int gw, int ngw, int wave, int lane, size_t gtid, size_t nthr) {
    LAS float* scr = (LAS float*)(lds + wave * 8704);
    unsigned char* ws = p.ws;
    constexpr int I_GU = 176 * 16, I_D = 32 * 44, I_KV = 16 * 16, I_O = 32 * 16, I_0 = 80 * 16, I_1 = 112 * 16;
    constexpr int NITEMS = 4 * I_GU + 4 * I_D + 2 * I_KV + 2 * I_O + I_0 + I_1;
    const int l31 = 4 * (lane & 7);
    for (int it = gw; it < NITEMS; it += ngw) {
        int r = it;
        if (r < 4 * I_GU) { const int m = r / I_GU; r -= m * I_GU; const int kb = r / 176, nb = r % 176, row = nb * 32 + l31, pn = row >> 8, bj = (row >> 7) & 1, j = row & 127;
            tr_item((bj ? p.wu : p.wg) + (size_t)m * 1024 * FF + 128 * pn + j, FF, (bf16_t*)(ws + OFF_WGU + m * SZ_WGU), 1024, nb * 32, kb * 64, scr, lane); continue; }
        r -= 4 * I_GU;
        if (r < 4 * I_D) { const int m = r / I_D; r -= m * I_D; const int kb = r >> 5, nb = r & 31, row = nb * 32 + l31;
            tr_item(p.wd + (size_t)m * FF * 1024 + row, 1024, (bf16_t*)(ws + OFF_WD + m * SZ_WD), FF, nb * 32, kb * 64, scr, lane); continue; }
        r -= 4 * I_D;
        if (r < 2 * I_KV) { const int m = r / I_KV; r -= m * I_KV; const int kb = r >> 4, nb = r & 15, row = nb * 32 + l31;
            tr_item(p.wkv + (size_t)m * 1024 * 512 + row, 512, (bf16_t*)(ws + OFF_WKV + m * SZ_WKV), 1024, nb * 32, kb * 64, scr, lane); continue; }
        r -= 2 * I_KV;
        if (r < 2 * I_O) { const int m = r / I_O; r -= m * I_O; const int kb = r >> 5, nb = r & 31, row = nb * 32 + l31;
            tr_item(p.wout + (size_t)m * 1024 * 1024 + row, 1024, (bf16_t*)(ws + OFF_WOUT + m * SZ_WOUT), 1024, nb * 32, kb * 64, scr, lane); continue; }
        r -= 2 * I_O;
        if (r < I_0) { const int kb = r / 80, nb = r % 80, row = nb * 32 + l31;
            tr_item(p.win0 + row, LDU0, (bf16_t*)(ws + OFF_WIN0), 1024, nb * 32, kb * 64, scr, lane); continue; }
        r -= I_0;
        { const int kb = r / 112, nb = r % 112, row = nb * 32 + l31;
          const int col = row < 3072 ? row : (row < 3328 ? row + 8 : (row < 3336 ? row - 256 : -1));
          tr_item(col >= 0 ? p.win1 + col : (const float*)nullptr, NS1, (bf16_t*)(ws + OFF_WIN1), 1024, nb * 32, kb * 64, scr, lane); }
    }
    cvt_rows(p.x, (bf16_t*)(ws + OFF_XB), (size_t)NTOK * DM / 8, gtid, nthr);
    cvt_rows(p.mem, (bf16_t*)(ws + OFF_MEMB), (size_t)2048 * DM / 8, gtid, nthr);
}

__device__ __forceinline__ void ln_phase(const float* Xin, float* Xout, bf16_t* XB, const float* g, const float* b, bool wf32, bool wbf, int gw, int ngw, int lane) {
    f32x4 gv[4], bv[4];
#pragma unroll
    for (int j = 0; j < 4; ++j) { gv[j] = ((const f32x4*)g)[lane + 64 * j]; bv[j] = ((const f32x4*)b)[lane + 64 * j]; }
    for (int row0 = gw * 4; row0 < NTOK; row0 += ngw * 4) {
        f32x4 v[4][4]; float s[4], s2[4];
#pragma unroll
        for (int r = 0; r < 4; ++r) { const f32x4* xr = (const f32x4*)(Xin + (size_t)(row0 + r) * DM) + lane;
#pragma unroll
            for (int j = 0; j < 4; ++j) v[r][j] = xr[64 * j]; }
#pragma unroll
        for (int r = 0; r < 4; ++r) { s[r] = 0.f;
#pragma unroll
            for (int j = 0; j < 4; ++j) s[r] += (v[r][j][0] + v[r][j][1]) + (v[r][j][2] + v[r][j][3]); }
#pragma unroll
        for (int o = 1; o < 64; o <<= 1)
#pragma unroll
            for (int r = 0; r < 4; ++r) s[r] += __shfl_xor(s[r], o);
#pragma unroll
        for (int r = 0; r < 4; ++r) { const float mean = s[r] * (1.f / DM); s2[r] = 0.f;
#pragma unroll
            for (int j = 0; j < 4; ++j) { v[r][j] = v[r][j] - mean; s2[r] += (v[r][j][0] * v[r][j][0] + v[r][j][1] * v[r][j][1]) + (v[r][j][2] * v[r][j][2] + v[r][j][3] * v[r][j][3]); } }
#pragma unroll
        for (int o = 1; o < 64; o <<= 1)
#pragma unroll
            for (int r = 0; r < 4; ++r) s2[r] += __shfl_xor(s2[r], o);
#pragma unroll
        for (int r = 0; r < 4; ++r) {
            const float rstd = 1.0f / sqrtf(s2[r] * (1.f / DM) + LN_EPS);
            f32x4* xo = (f32x4*)(Xout + (size_t)(row0 + r) * DM) + lane;
            u32x2* bo = (u32x2*)(XB + (size_t)(row0 + r) * DM) + lane;
#pragma unroll
            for (int j = 0; j < 4; ++j) { const f32x4 y = v[r][j] * rstd * gv[j] + bv[j]; if (wf32) xo[64 * j] = y; if (wbf) { u32x2 w; w.x = pk2(y[0], y[1]); w.y = pk2(y[2], y[3]); bo[64 * j] = w; } }
        }
    }
}

__device__ __forceinline__ void conv_phase(const bf16_t* U, const float* cw, bf16_t* MIX, size_t gtid, size_t nthr) {
    for (size_t i = gtid; i < (size_t)NTOK * 96; i += nthr) {
        const int tok = (int)(i / 96), cgi = (int)(i % 96), pos = tok & (SEQ - 1);
        const bf16_t* up = U + (size_t)tok * LDU0 + cgi * 8;
        const u32x4 bg = *(const u32x4*)up;
        float acc[8];
#pragma unroll
        for (int e = 0; e < 8; ++e) acc[e] = 0.f;
#pragma unroll
        for (int j = 0; j < 3; ++j) {
            if (pos - j >= 0) {
                const u32x4 c = *(const u32x4*)(up - (size_t)j * LDU0 + 768), xi = *(const u32x4*)(up - (size_t)j * LDU0 + 1536);
                const f32x4 w0 = *(const f32x4*)(cw + (2 - j) * 768 + cgi * 8), w1 = *(const f32x4*)(cw + (2 - j) * 768 + cgi * 8 + 4);
                acc[0] += w0[0] * LO16(c.x) * LO16(xi.x); acc[1] += w0[1] * HI16(c.x) * HI16(xi.x);
                acc[2] += w0[2] * LO16(c.y) * LO16(xi.y); acc[3] += w0[3] * HI16(c.y) * HI16(xi.y);
                acc[4] += w1[0] * LO16(c.z) * LO16(xi.z); acc[5] += w1[1] * HI16(c.z) * HI16(xi.z);
                acc[6] += w1[2] * LO16(c.w) * LO16(xi.w); acc[7] += w1[3] * HI16(c.w) * HI16(xi.w);
            }
        }
        u32x4 o;
        o.x = pk2(LO16(bg.x) * acc[0], HI16(bg.x) * acc[1]); o.y = pk2(LO16(bg.y) * acc[2], HI16(bg.y) * acc[3]);
        o.z = pk2(LO16(bg.z) * acc[4], HI16(bg.z) * acc[5]); o.w = pk2(LO16(bg.w) * acc[6], HI16(bg.w) * acc[7]);
        *(u32x4*)(MIX + (size_t)tok * DM + cgi * 8) = o;
    }
}

__device__ __forceinline__ void xattn_phase(LAS unsigned char* lds, const bf16_t* U, int ldu, int qoff, const bf16_t* KV, bf16_t* MIX, int tid) {
    const int wave = tid >> 6, lane = tid & 63, fr = lane & 15, fq = lane >> 4;
    LAS bf16_t* Ks = (LAS bf16_t*)lds;
    LAS bf16_t* Vt = Ks + 256 * 72;
    for (int item = blockIdx.x; item < 256; item += gridDim.x) {
        const int b = item >> 5, hd = (item >> 3) & 3, tc = item & 7;
        __syncthreads();
#pragma unroll
        for (int i = 0; i < 4; ++i) {
            const int id = tid + 512 * i, key = id >> 3, dc = id & 7;
            const bf16_t* src = KV + (size_t)(b * 256 + key) * 1024 + hd * 64 + dc * 8;
            const u32x4 kk = *(const u32x4*)src, vv = *(const u32x4*)(src + 256);
            *(LAS u32x4*)(Ks + key * 72 + dc * 8) = kk;
            const int kb = key >> 4, q4 = (key >> 2) & 3, e4 = key & 3, pos = (kb >> 1) * 32 + q4 * 8 + (kb & 1) * 4 + e4;
            LAS bf16_t* vd = Vt + (dc * 8) * 264 + pos;
            vd[0] = (bf16_t)(vv.x & 0xffffu); vd[264] = (bf16_t)(vv.x >> 16); vd[2 * 264] = (bf16_t)(vv.y & 0xffffu); vd[3 * 264] = (bf16_t)(vv.y >> 16);
            vd[4 * 264] = (bf16_t)(vv.z & 0xffffu); vd[5 * 264] = (bf16_t)(vv.z >> 16); vd[6 * 264] = (bf16_t)(vv.w & 0xffffu); vd[7 * 264] = (bf16_t)(vv.w >> 16);
        }
        __syncthreads();
#pragma unroll 1
        for (int tt = 0; tt < 4; ++tt) {
            asm volatile("" ::: "memory");
            const int tok0 = b * SEQ + tc * 512 + (wave * 4 + tt) * 16;
            const bf16_t* qp = U + (size_t)(tok0 + fr) * ldu + qoff + hd * 64 + fq * 8;
            const bf16x8 qf0 = *(const bf16x8*)qp, qf1 = *(const bf16x8*)(qp + 32);
            f32x4 s[16];
#pragma unroll
            for (int kb = 0; kb < 16; ++kb) {
                const LAS bf16_t* kp = Ks + (kb * 16 + fr) * 72 + fq * 8;
                f32x4 a = {0.f, 0.f, 0.f, 0.f};
                a = MFMA16(*(const LAS bf16x8*)kp, qf0, a);
                a = MFMA16(*(const LAS bf16x8*)(kp + 32), qf1, a);
                s[kb] = a;
            }
            float mx = -3.0e38f;
#pragma unroll
            for (int kb = 0; kb < 16; ++kb) mx = fmaxf(mx, fmaxf(fmaxf(s[kb][0], s[kb][1]), fmaxf(s[kb][2], s[kb][3])));
            mx = fmaxf(mx, __shfl_xor(mx, 16)); mx = fmaxf(mx, __shfl_xor(mx, 32));
            const float sc = 0.125f * 1.44269504089f; float sum = 0.f;
#pragma unroll
            for (int kb = 0; kb < 16; ++kb)
#pragma unroll
                for (int j = 0; j < 4; ++j) { const float pe = exp2f((s[kb][j] - mx) * sc); s[kb][j] = pe; sum += pe; }
            sum += __shfl_xor(sum, 16); sum += __shfl_xor(sum, 32);
            const float inv = 1.0f / sum;
            f32x4 o[4];
#pragma unroll
            for (int dn = 0; dn < 4; ++dn) o[dn] = (f32x4){0.f, 0.f, 0.f, 0.f};
#pragma unroll
            for (int ks = 0; ks < 8; ++ks) {
                u32x4 pw; pw.x = pk2(s[2 * ks][0], s[2 * ks][1]); pw.y = pk2(s[2 * ks][2], s[2 * ks][3]); pw.z = pk2(s[2 * ks + 1][0], s[2 * ks + 1][1]); pw.w = pk2(s[2 * ks + 1][2], s[2 * ks + 1][3]);
                const bf16x8 pf = __builtin_bit_cast(bf16x8, pw);
#pragma unroll
                for (int dn = 0; dn < 4; ++dn) o[dn] = MFMA16(*(const LAS bf16x8*)(Vt + (dn * 16 + fr) * 264 + ks * 32 + fq * 8), pf, o[dn]);
            }
            bf16_t* op = MIX + (size_t)(tok0 + fr) * DM + 768 + hd * 64 + fq * 4;
#pragma unroll
            for (int dn = 0; dn < 4; ++dn) { u32x2 w; w.x = pk2(o[dn][0] * inv, o[dn][1] * inv); w.y = pk2(o[dn][2] * inv, o[dn][3] * inv); *(u32x2*)(op + dn * 16) = w; }
        }
    }
}

__device__ __forceinline__ void m0_phase(const float* GATES, const float* bg, float* GB, float* GLI, float* GM, int gw, int ngw, int lane) {
    for (int item = gw; item < 2048; item += ngw) {
        const int bh = item >> 6, c = item & 63, b = bh >> 2, h = bh & 3;
        const size_t tok = (size_t)b * SEQ + c * 64 + lane;
        const float ip = GATES[tok * 8 + h] + bg[h], fp = GATES[tok * 8 + 4 + h] + bg[4 + h];
        const float lf = fminf(fp, 0.f) - log1pf(expf(-fabsf(fp)));
        float bc = lf;
#pragma unroll
        for (int o = 1; o < 64; o <<= 1) { const float t = __shfl_up(bc, o); if (lane >= o) bc += t; }
        const float bl = __shfl(bc, 63);
        const float mxl = wmax(bl - bc + ip);
        GB[(size_t)bh * SEQ + c * 64 + lane] = bc; GLI[(size_t)bh * SEQ + c * 64 + lane] = ip;
        if (lane == 0) { GM[6144 + item] = bl; GM[8192 + item] = mxl; }
    }
}
__device__ __forceinline__ void chunk_stab(const float* GM, int bh, int c, int lane, float& mst_c, float& mnew_c, float& dec_c) {
    const float bl = GM[6144 + bh * 64 + lane], ml = GM[8192 + bh * 64 + lane];
    float B = bl;
#pragma unroll
    for (int o = 1; o < 64; o <<= 1) { const float t = __shfl_up(B, o); if (lane >= o) B += t; }
    float pm = ml - B;
#pragma unroll
    for (int o = 1; o < 64; o <<= 1) { const float t = __shfl_up(pm, o); if (lane >= o) pm = fmaxf(pm, t); }
    const float mnew = B + fmaxf(0.f, pm);
    const float mprev = __shfl_up(mnew, 1);
    const float mst = lane == 0 ? 0.f : mprev;
    const float dec = expf(bl + mst - mnew);
    mst_c = __int_as_float(__builtin_amdgcn_readlane(__float_as_int(mst), c));
    mnew_c = __int_as_float(__builtin_amdgcn_readlane(__float_as_int(mnew), c));
    dec_c = __int_as_float(__builtin_amdgcn_readlane(__float_as_int(dec), c));
}

__device__ __forceinline__ void qk_conv8(const bf16_t* U, const float* qkw, size_t tok, int pos, int col, float (&r)[8]) {
#pragma unroll
    for (int e = 0; e < 8; ++e) r[e] = 0.f;
#pragma unroll
    for (int j = 0; j < 4; ++j) {
        if (pos - j >= 0) {
            const u32x4 v = *(const u32x4*)(U + (tok - j) * LDU1 + col);
            const f32x4 w0 = *(const f32x4*)(qkw + (3 - j) * 1536 + col), w1 = *(const f32x4*)(qkw + (3 - j) * 1536 + col + 4);
            r[0] += w0[0] * LO16(v.x); r[1] += w0[1] * HI16(v.x); r[2] += w0[2] * LO16(v.y); r[3] += w0[3] * HI16(v.y);
            r[4] += w1[0] * LO16(v.z); r[5] += w1[1] * HI16(v.z); r[6] += w1[2] * LO16(v.w); r[7] += w1[3] * HI16(v.w);
        }
    }
#pragma unroll
    for (int e = 0; e < 8; ++e) r[e] = silu_f(r[e]);
}

__device__ __forceinline__ void m1_phase(LAS unsigned char* lds, const bf16_t* U, const float* qkw, const float* GB, const float* GLI, const float* GM, float* GMW, bf16_t* CBUF, float* NBUF, int tid) {
    const int wave = tid >> 6, lane = tid & 63, fr = lane & 15, fq = lane >> 4;
    LAS bf16_t* KT = (LAS bf16_t*)lds;
    LAS bf16_t* VT = KT + 192 * 72;
    for (int item = blockIdx.x; item < 2048; item += gridDim.x) {
        const int bh = item >> 6, c = item & 63, b = bh >> 2, h = bh & 3;
        const size_t tok0 = (size_t)b * SEQ + c * 64;
        __syncthreads();
        {
            const int s = tid & 63, g0 = tid >> 6;
            const size_t gi = (size_t)bh * SEQ + c * 64;
            float mst_c, mnew_c, dec_c; chunk_stab(GM, bh, c, lane, mst_c, mnew_c, dec_c);
            if (tid == 0) { GMW[bh * 64 + c] = mst_c; GMW[2048 + bh * 64 + c] = mnew_c; GMW[4096 + bh * 64 + c] = dec_c; }
            const float wk = __expf(GB[gi + 63] - GB[gi + s] + GLI[gi + s] - mnew_c) * RS192;
#pragma unroll 1
            for (int it = 0; it < 3; ++it) {
                const int g = g0 + 8 * it, ch = h * 192 + g * 8;
                float kv[8];
                qk_conv8(U, qkw, tok0 + s, c * 64 + s, 768 + ch, kv);
                const u32x4 vv = *(const u32x4*)(U + (tok0 + s) * LDU1 + 1536 + ch);
                LAS bf16_t* kd = KT + (g * 8) * 72 + s; LAS bf16_t* vd = VT + (g * 8) * 72 + s;
#pragma unroll
                for (int e = 0; e < 8; ++e) kd[e * 72] = (bf16_t)f2bf(kv[e] * wk);
                vd[0] = (bf16_t)(vv.x & 0xffffu); vd[72] = (bf16_t)(vv.x >> 16); vd[2 * 72] = (bf16_t)(vv.y & 0xffffu); vd[3 * 72] = (bf16_t)(vv.y >> 16);
                vd[4 * 72] = (bf16_t)(vv.z & 0xffffu); vd[5 * 72] = (bf16_t)(vv.z >> 16); vd[6 * 72] = (bf16_t)(vv.w & 0xffffu); vd[7 * 72] = (bf16_t)(vv.w >> 16);
            }
        }
        __syncthreads();
        if (tid < 192) { float sm = 0.f;
#pragma unroll 8
            for (int s = 0; s < 64; ++s) sm += bf2f(KT[tid * 72 + s]);
            NBUF[(size_t)(bh * 64 + c) * 192 + tid] = sm; }
        bf16_t* cb = CBUF + (size_t)(bh * 64 + c) * 36864;
#pragma unroll 2
        for (int i = 0; i < 18; ++i) {
            const int idx = wave * 18 + i, dkt = idx / 12, dvt = idx % 12;
            const LAS bf16_t* ap = KT + (dkt * 16 + fr) * 72 + fq * 8; const LAS bf16_t* bp = VT + (dvt * 16 + fr) * 72 + fq * 8;
            f32x4 a = {0.f, 0.f, 0.f, 0.f};
            a = MFMA16(*(const LAS bf16x8*)ap, *(const LAS bf16x8*)bp, a);
            a = MFMA16(*(const LAS bf16x8*)(ap + 32), *(const LAS bf16x8*)(bp + 32), a);
            u32x2 w; w.x = pk2(a[0], a[1]); w.y = pk2(a[2], a[3]);
            *(u32x2*)(cb + (size_t)(dvt * 16 + fr) * 192 + dkt * 16 + fq * 4) = w;
        }
    }
}

__device__ __forceinline__ void m2_phase(bf16_t* CBUF, float* NBUF, const float* GM, int tidx) {
    for (int i = (int)blockIdx.x * 288 + tidx; tidx < 288 && i < 32 * 2304; i += (int)gridDim.x * 288) {
        const int bh = i / 2304, e = i % 2304;
        bf16_t* ptr = CBUF + (size_t)bh * 64 * 36864 + e * 16;
        const float* dec = GM + 4096 + bh * 64;
        float r[16];
#pragma unroll
        for (int k = 0; k < 16; ++k) r[k] = 0.f;
#pragma unroll 4
        for (int c = 0; c < 64; ++c) {
            const u32x4 d0 = *(const u32x4*)(ptr + (size_t)c * 36864), d1 = *(const u32x4*)(ptr + (size_t)c * 36864 + 8);
            u32x4 w0, w1;
            w0.x = pk2(r[0], r[1]); w0.y = pk2(r[2], r[3]); w0.z = pk2(r[4], r[5]); w0.w = pk2(r[6], r[7]);
            w1.x = pk2(r[8], r[9]); w1.y = pk2(r[10], r[11]); w1.z = pk2(r[12], r[13]); w1.w = pk2(r[14], r[15]);
            *(u32x4*)(ptr + (size_t)c * 36864) = w0; *(u32x4*)(ptr + (size_t)c * 36864 + 8) = w1;
            const float dc = dec[c];
            r[0] = dc * r[0] + LO16(d0.x); r[1] = dc * r[1] + HI16(d0.x); r[2] = dc * r[2] + LO16(d0.y); r[3] = dc * r[3] + HI16(d0.y);
            r[4] = dc * r[4] + LO16(d0.z); r[5] = dc * r[5] + HI16(d0.z); r[6] = dc * r[6] + LO16(d0.w); r[7] = dc * r[7] + HI16(d0.w);
            r[8] = dc * r[8] + LO16(d1.x); r[9] = dc * r[9] + HI16(d1.x); r[10] = dc * r[10] + LO16(d1.y); r[11] = dc * r[11] + HI16(d1.y);
            r[12] = dc * r[12] + LO16(d1.z); r[13] = dc * r[13] + HI16(d1.z); r[14] = dc * r[14] + LO16(d1.w); r[15] = dc * r[15] + HI16(d1.w);
        }
    }
    if (tidx >= 288 && tidx < 312) {
        for (int i = (int)blockIdx.x * 24 + (tidx - 288); i < 32 * 192; i += (int)gridDim.x * 24) {
            const int bh = i / 192, e = i % 192;
            float* ptr = NBUF + (size_t)bh * 64 * 192 + e;
            const float* dec = GM + 4096 + bh * 64;
            float r = 0.f;
            for (int c = 0; c < 64; ++c) { const float d = ptr[c * 192]; ptr[c * 192] = r; r = dec[c] * r + d; }
        }
    }
}

__device__ __forceinline__ void m3_phase(LAS unsigned char* lds, const bf16_t* U, const float* qkw, const float* hng, const float* GB, const float* GLI, const float* GM,
                                         const bf16_t* CBUF, const float* NBUF, bf16_t* MIX, int tid) {
    const int wave = tid >> 6, lane = tid & 63, fr = lane & 15, fq = lane >> 4;
    LAS bf16_t* Qs = (LAS bf16_t*)lds;
    LAS bf16_t* Ks = (LAS bf16_t*)(lds + 25600);
    LAS bf16_t* VT = (LAS bf16_t*)(lds + 51200);
    LAS bf16_t* CT = (LAS bf16_t*)(lds + 78848);
    LAS float* Hs = (LAS float*)(lds + 78848);
    LAS float* nS = (LAS float*)(lds + 155648);
    LAS float* bcS = nS + 192; LAS float* liS = bcS + 64; LAS float* mtS = liS + 64; LAS float* winS = mtS + 64; LAS float* qnS = winS + 64; LAS float* denP = qnS + 64;
    LAS bf16_t* Ps = Ks;
    for (int item = blockIdx.x; item < 2048; item += gridDim.x) {
        const int bh = item >> 6, c = item & 63, b = bh >> 2, h = bh & 3;
        const size_t tok0 = (size_t)b * SEQ + c * 64;
        __syncthreads();
#ifdef M3_DUP_STAGE
#pragma unroll 1
        for (int rep_ = 0; rep_ < 2; ++rep_) { if (rep_) { asm volatile("s_waitcnt vmcnt(0)" ::: "memory"); __syncthreads(); }
#else
        {
#endif
        {
            const bf16_t* cb = CBUF + (size_t)(bh * 64 + c) * 36864;
#pragma unroll
            for (int i = 0; i < 9; ++i) { const int P = tid + 512 * i, row = P / 24, slot = P % 24, chk = slot ^ ((row >> 1) & 7);
                __builtin_amdgcn_global_load_lds((const unsigned*)(cb + (size_t)row * 192 + chk * 8), (LAS unsigned*)((LAS unsigned char*)CT + (wave * 64 + 512 * i) * 16), 16, 0, 0); }
        }
        if (tid < 384) {
            const int g = tid % 24, r = tid / 24, ch = h * 192 + g * 8;
#pragma unroll 1
            for (int qk = 0; qk < 2; ++qk) {
                const int col = qk * 768 + ch; const float scl = qk ? RS192 : 1.0f; LAS bf16_t* dst = qk ? Ks : Qs;
                u32x4 rw[7];
#pragma unroll
                for (int i = 0; i < 7; ++i) {
                    const int sp = 4 * r - 3 + i;
                    if (c * 64 + sp >= 0) rw[i] = *(const u32x4*)(U + (size_t)((long)tok0 + sp) * LDU1 + col); else rw[i] = (u32x4){0u, 0u, 0u, 0u};
                }
                f32x4 wv[4][2];
#pragma unroll
                for (int j = 0; j < 4; ++j) { wv[j][0] = *(const f32x4*)(qkw + j * 1536 + col); wv[j][1] = *(const f32x4*)(qkw + j * 1536 + col + 4); }
#pragma unroll
                for (int si = 0; si < 4; ++si) {
                    float v[8];
#pragma unroll
                    for (int e = 0; e < 8; ++e) v[e] = 0.f;
#pragma unroll
                    for (int j = 0; j < 4; ++j) {
                        const u32x4 a = rw[si + j];
                        v[0] += wv[j][0][0] * LO16(a.x); v[1] += wv[j][0][1] * HI16(a.x); v[2] += wv[j][0][2] * LO16(a.y); v[3] += wv[j][0][3] * HI16(a.y);
                        v[4] += wv[j][1][0] * LO16(a.z); v[5] += wv[j][1][1] * HI16(a.z); v[6] += wv[j][1][2] * LO16(a.w); v[7] += wv[j][1][3] * HI16(a.w);
                    }
#pragma unroll
                    for (int e = 0; e < 8; ++e) v[e] = silu_f(v[e]) * scl;
                    u32x4 w; w.x = pk2(v[0], v[1]); w.y = pk2(v[2], v[3]); w.z = pk2(v[4], v[5]); w.w = pk2(v[6], v[7]);
                    *(LAS u32x4*)(dst + (4 * r + si) * 200 + g * 8) = w;
                }
                asm volatile("" ::: "memory");
            }
        }
        {
            const int s = tid & 63, g0 = tid >> 6;
#pragma unroll
            for (int it = 0; it < 3; ++it) {
                const int g = g0 + 8 * it, ch = h * 192 + g * 8;
                const u32x4 vv = *(const u32x4*)(U + (tok0 + s) * LDU1 + 1536 + ch);
                LAS bf16_t* vd = VT + (g * 8) * 72 + s;
                vd[0] = (bf16_t)(vv.x & 0xffffu); vd[72] = (bf16_t)(vv.x >> 16); vd[2 * 72] = (bf16_t)(vv.y & 0xffffu); vd[3 * 72] = (bf16_t)(vv.y >> 16);
                vd[4 * 72] = (bf16_t)(vv.z & 0xffffu); vd[5 * 72] = (bf16_t)(vv.z >> 16); vd[6 * 72] = (bf16_t)(vv.w & 0xffffu); vd[7 * 72] = (bf16_t)(vv.w >> 16);
            }
        }
        {
            if (tid < 192) nS[tid] = NBUF[(size_t)(bh * 64 + c) * 192 + tid];
            if (tid < 64) { bcS[tid] = GB[(size_t)bh * SEQ + c * 64 + tid]; liS[tid] = GLI[(size_t)bh * SEQ + c * 64 + tid]; }
        }
        }
        const float mst = GM[bh * 64 + c];
        asm volatile("s_waitcnt vmcnt(0)" ::: "memory");
        __syncthreads();
        if (wave == 0) {
            const float bc = bcS[lane]; float pm = liS[lane] - bc;
#pragma unroll
            for (int o = 1; o < 64; o <<= 1) { const float t = __shfl_up(pm, o); if (lane >= o) pm = fmaxf(pm, t); }
            const float mt = bc + fmaxf(mst, pm);
            mtS[lane] = mt; winS[lane] = __expf(bc + mst - mt);
        }
        {
            const int t = tid >> 3, part = tid & 7; float sm = 0.f;
#pragma unroll 8
            for (int d = 0; d < 24; ++d) sm += bf2f(Qs[t * 200 + part * 24 + d]) * nS[part * 24 + d];
            sm += __shfl_xor(sm, 1); sm += __shfl_xor(sm, 2); sm += __shfl_xor(sm, 4);
            if (part == 0) qnS[t] = sm;
        }
        f32x4 sacc[2];
#pragma unroll
        for (int i = 0; i < 2; ++i) {
            const int tile = wave * 2 + i, tt = tile >> 2, st = tile & 3;
            const LAS bf16_t* ap = Qs + (tt * 16 + fr) * 200 + fq * 8; const LAS bf16_t* bp = Ks + (st * 16 + fr) * 200 + fq * 8;
            f32x4 a = {0.f, 0.f, 0.f, 0.f};
#pragma unroll
            for (int ks = 0; ks < 6; ++ks) a = MFMA16(*(const LAS bf16x8*)(ap + ks * 32), *(const LAS bf16x8*)(bp + ks * 32), a);
            sacc[i] = a;
        }
        __syncthreads();
#pragma unroll
        for (int i = 0; i < 2; ++i) {
            const int tile = wave * 2 + i, tt = tile >> 2, st = tile & 3, s = st * 16 + fr;
            const float gs = liS[s] - bcS[s];
#pragma unroll
            for (int j = 0; j < 4; ++j) {
                const int t = tt * 16 + fq * 4 + j;
                const float w = (s <= t) ? __expf(bcS[t] + gs - mtS[t]) : 0.f;
                const float scv = sacc[i][j] * w;
                Ps[t * 72 + s] = (bf16_t)f2bf(scv);
                float rs = scv; rs += __shfl_xor(rs, 1); rs += __shfl_xor(rs, 2); rs += __shfl_xor(rs, 4); rs += __shfl_xor(rs, 8);
                if (fr == 0) denP[t * 4 + st] = rs;
            }
        }
        __syncthreads();
        f32x4 hv[6];
        {
            const int tt = wave >> 1, dvt0 = (wave & 1) * 6;
            const LAS bf16_t* pp = Ps + (tt * 16 + fr) * 72 + fq * 8; const LAS bf16_t* qp = Qs + (tt * 16 + fr) * 200 + fq * 8;
            const bf16x8 pa0 = *(const LAS bf16x8*)pp, pa1 = *(const LAS bf16x8*)(pp + 32);
            bf16x8 qa[6];
#pragma unroll
            for (int ks = 0; ks < 6; ++ks) qa[ks] = *(const LAS bf16x8*)(qp + ks * 32);
            float win[4], rden[4];
#pragma unroll
            for (int j = 0; j < 4; ++j) { const int t = tt * 16 + fq * 4 + j; win[j] = winS[t];
                const float den = (denP[t * 4] + denP[t * 4 + 1]) + (denP[t * 4 + 2] + denP[t * 4 + 3]) + win[j] * qnS[t];
                rden[j] = 1.0f / fmaxf(fabsf(den), __expf(-mtS[t])); }
#pragma unroll
            for (int i = 0; i < 6; ++i) {
                const int dvt = dvt0 + i;
                const LAS bf16_t* vp = VT + (dvt * 16 + fr) * 72 + fq * 8; const LAS bf16_t* cp = CT + (dvt * 16 + fr) * 192; const int csw = (fr >> 1) & 7;
                f32x4 ia = {0.f, 0.f, 0.f, 0.f}, ie = {0.f, 0.f, 0.f, 0.f};
                ia = MFMA16(pa0, *(const LAS bf16x8*)vp, ia); ia = MFMA16(pa1, *(const LAS bf16x8*)(vp + 32), ia);
#pragma unroll
                for (int ks = 0; ks < 6; ++ks) ie = MFMA16(qa[ks], *(const LAS bf16x8*)(cp + ((ks * 4 + fq) ^ csw) * 8), ie);
#pragma unroll
                for (int j = 0; j < 4; ++j) hv[i][j] = (ia[j] + win[j] * ie[j]) * rden[j];
            }
        }
        __syncthreads();
        {
            const int tt = wave >> 1, dvt0 = (wave & 1) * 6;
#pragma unroll
            for (int i = 0; i < 6; ++i)
#pragma unroll
                for (int j = 0; j < 4; ++j) Hs[(tt * 16 + fq * 4 + j) * 196 + (dvt0 + i) * 16 + fr] = hv[i][j];
        }
        __syncthreads();
#ifdef M3_DUP_HN
#pragma unroll 1
        for (int rep_ = 0; rep_ < 2; ++rep_)
#endif
        {
            const float g0 = hng[h * 192 + lane], g1 = hng[h * 192 + lane + 64], g2 = hng[h * 192 + lane + 128];
#pragma unroll 1
            for (int rb = 0; rb < 2; ++rb) {
                float x[4][3], og[4][3];
#pragma unroll
                for (int r = 0; r < 4; ++r) { const int t = wave * 8 + rb * 4 + r;
                    const bf16_t* op = U + (tok0 + t) * LDU1 + 2304 + h * 192 + lane;
                    og[r][0] = bf2f(op[0]); og[r][1] = bf2f(op[64]); og[r][2] = bf2f(op[128]);
                    x[r][0] = Hs[t * 196 + lane]; x[r][1] = Hs[t * 196 + lane + 64]; x[r][2] = Hs[t * 196 + lane + 128]; }
                float mean[4], var[4];
#pragma unroll
                for (int r = 0; r < 4; ++r) mean[r] = x[r][0] + x[r][1] + x[r][2];
#pragma unroll
                for (int o = 1; o < 64; o <<= 1)
#pragma unroll
                    for (int r = 0; r < 4; ++r) mean[r] += __shfl_xor(mean[r], o);
#pragma unroll
                for (int r = 0; r < 4; ++r) { mean[r] *= (1.f / 192.f); x[r][0] -= mean[r]; x[r][1] -= mean[r]; x[r][2] -= mean[r]; var[r] = x[r][0] * x[r][0] + x[r][1] * x[r][1] + x[r][2] * x[r][2]; }
#pragma unroll
                for (int o = 1; o < 64; o <<= 1)
#pragma unroll
                    for (int r = 0; r < 4; ++r) var[r] += __shfl_xor(var[r], o);
#pragma unroll
                for (int r = 0; r < 4; ++r) { const int t = wave * 8 + rb * 4 + r;
                    const float rstd = 1.0f / sqrtf(var[r] * (1.f / 192.f) + LN_EPS);
                    bf16_t* mp = MIX + (tok0 + t) * DM + h * 192 + lane;
                    mp[0] = (bf16_t)f2bf(sigmoid_f(og[r][0]) * (x[r][0] * rstd * g0));
                    mp[64] = (bf16_t)f2bf(sigmoid_f(og[r][1]) * (x[r][1] * rstd * g1));
                    mp[128] = (bf16_t)f2bf(sigmoid_f(og[r][2]) * (x[r][2] * rstd * g2)); }
            }
        }
    }
}

#define XB_TMO      128
#define XB_XCNT(j)  (256  + 64 * (j))
#define XB_XSUB(j)  (1280 + 64 * (j))
#define XB_XGEN(j)  (2304 + 64 * (j))
#define XB_TOP      3328
#define XB_TOPGEN   3392
#define XCD_BAR_WORDS 3456
#define XB_SPIN_CAP (1u << 18)
__device__ __forceinline__ unsigned xb_ld(unsigned* p)              { return __hip_atomic_load(p, __ATOMIC_RELAXED, __HIP_MEMORY_SCOPE_AGENT); }
__device__ __forceinline__ unsigned xb_add(unsigned* p, unsigned v) { return __hip_atomic_fetch_add(p, v, __ATOMIC_RELAXED, __HIP_MEMORY_SCOPE_AGENT); }
__device__ __forceinline__ unsigned xb_xcc_id() { return (unsigned)__builtin_amdgcn_s_getreg((3 << 11) | 20) & 0xFu; }
#define XB_SPIN(cond, bar) do { unsigned _sp = 0; while (cond) { __builtin_amdgcn_s_sleep(1); \
    if ((++_sp & 255u) == 0u) { if (xb_ld(&(bar)[XB_TMO])) break; if (_sp > XB_SPIN_CAP) { atomicAdd(&(bar)[XB_TMO], 1u); break; } } } } while (0)
__device__ __forceinline__ void xcd_barrier_complete(unsigned* bar, unsigned x, unsigned& nloc, unsigned& nx) {
    const unsigned G = gridDim.x * gridDim.y * gridDim.z;
    unsigned sum, cnt, mine, sp = 0u;
    for (;;) {
        sum = 0u; cnt = 0u; mine = 0u;
#pragma unroll
        for (unsigned j = 0; j < 16; ++j) { const unsigned c = xb_ld(&bar[XB_XCNT(j)]); sum += c; cnt += (c > 0u) ? 1u : 0u; mine = (j == x) ? c : mine; }
        if (sum == G) break;
        __builtin_amdgcn_s_sleep(1);
        if ((++sp & 255u) == 0u) { if (xb_ld(&bar[XB_TMO])) break; if (sp > XB_SPIN_CAP) { atomicAdd(&bar[XB_TMO], 1u); break; } }
    }
    nloc = mine > 0u ? mine : 1u; nx = cnt > 0u ? cnt : 1u;
}
__device__ __forceinline__ void xcd_barrier(unsigned* bar, volatile LAS unsigned* st) {
    asm volatile("s_waitcnt vmcnt(0)" ::: "memory");
    __syncthreads();
    if (threadIdx.x == 0) {
        __builtin_amdgcn_s_waitcnt(0);
        const unsigned x = xb_xcc_id();
        unsigned nloc = st[0], nx = st[1];
        if (nloc == 0u) { xcd_barrier_complete(bar, x, nloc, nx); st[0] = nloc; st[1] = nx; }
        const unsigned old = xb_add(&bar[XB_XSUB(x)], 1u);
        const unsigned gen = old / nloc;
        if (old + 1u == (gen + 1u) * nloc) {
            __builtin_amdgcn_fence(__ATOMIC_RELEASE, "agent");
            asm volatile("s_waitcnt vmcnt(0)" ::: "memory");
            const unsigned og = xb_add(&bar[XB_TOP], 1u);
            const unsigned tg = og / nx;
            if (og + 1u == (tg + 1u) * nx) xb_add(&bar[XB_TOPGEN], 1u);
            else XB_SPIN(xb_ld(&bar[XB_TOPGEN]) == tg, bar);
            __builtin_amdgcn_fence(__ATOMIC_ACQUIRE, "agent");
            xb_add(&bar[XB_XGEN(x)], 1u);
            asm volatile("s_waitcnt vmcnt(0)" ::: "memory");
        } else {
            XB_SPIN(xb_ld(&bar[XB_XGEN(x)]) == gen, bar);
            __builtin_amdgcn_fence(__ATOMIC_ACQUIRE, "agent");
            asm volatile("s_waitcnt vmcnt(0)" ::: "memory");
        }
    }
    __syncthreads();
}

__device__ __forceinline__ int opaque_tid() { int t = threadIdx.x; asm volatile("" : "+v"(t)); return t; }
__global__ void __launch_bounds__(512, 2) fwd_kernel(Params p) {
    extern __shared__ __attribute__((aligned(16))) unsigned char shm[];
    LAS unsigned char* lds = (LAS unsigned char*)shm;
    cg::grid_group grid = cg::this_grid();
#define tid (opaque_tid())
#define wave (__builtin_amdgcn_readfirstlane(opaque_tid() >> 6))
#define lane (opaque_tid() & 63)
#define gw ((int)blockIdx.x * 8 + wave)
#define ngw ((int)gridDim.x * 8)
#define gtid ((size_t)blockIdx.x * 512 + opaque_tid())
#define nthr ((size_t)gridDim.x * 512)
    unsigned char* ws = p.ws;
    bf16_t* XB = (bf16_t*)(ws + OFF_XB); bf16_t* HU = (bf16_t*)(ws + OFF_HU); bf16_t* CBUF = (bf16_t*)(ws + OFF_CBUF);
    bf16_t* MEMB = (bf16_t*)(ws + OFF_MEMB); float* GATES = (float*)(ws + OFF_GATES); float* NBUF = (float*)(ws + OFF_NBUF);
    float* GB = (float*)(ws + OFF_GB); float* GLI = (float*)(ws + OFF_GLI); float* GM = (float*)(ws + OFF_GM);
    float* X = p.out;
    unsigned* bar = (unsigned*)(ws + OFF_BAR);
    volatile LAS unsigned* bst = (volatile LAS unsigned*)(lds + LDS_MAIN);
    if (threadIdx.x == 0) { bst[0] = 0u; bst[1] = 0u; (void)xb_add(&bar[XB_XCNT(xb_xcc_id())], 1u); }
    __syncthreads();
    if (gridDim.x == 0x7fffffffu) grid.sync();
#define GRID_SYNC() xcd_barrier(bar, bst)

#ifndef NO_PRO
#pragma unroll 1
    for (int i = 0; i < EXTRA_SYNC; ++i) GRID_SYNC();
    if (DUP_PRO) { prologue(p, lds, gw, ngw, wave, lane, gtid, nthr); GRID_SYNC(); }
    prologue(p, lds, gw, ngw, wave, lane, gtid, nthr);
#endif
    GRID_SYNC();

#pragma unroll 1
    for (int l = 0; l < 2; ++l) {
#pragma unroll 1
#ifdef DUP_M12
        for (int sti = 0; sti < 14 + (l == 1 ? 2 : 0); ++sti) {
            const int st = (l == 1 && sti > 7) ? sti - 2 : sti;
#else
        for (int sti = 0; sti < 14 + ((DUP_ST >= 0 && (DUP_L < 0 || DUP_L == l)) ? 1 : 0); ++sti) {
            const int st = (DUP_ST >= 0 && (DUP_L < 0 || DUP_L == l) && sti > DUP_ST) ? sti - 1 : sti;
#endif
            if (l == 0 && st >= 6 && st <= 8) continue;
            bf16_t* MEMKV = (bf16_t*)(ws + OFF_MEMKV) + l * 512;
            if (l == 1 && st == 3) continue;
            const int gk = (st == 0 || st == 11) ? 0 : (st == 1 || st == 12) ? 1 : st == 3 ? 2 : st == 4 ? 3 : st == 9 ? 4 : -1;
            if (gk >= 0) {
#ifndef NO_G1
                const int m = l * 2 + (st >= 11 ? 1 : 0);
                pg8::Gemm g; EpiAll E;
                E.O = HU; E.ldc = FF; E.nstore = 0; E.gates = GATES; E.gate_pn = -1; E.res = X; E.resb = nullptr; E.out = X; E.scale = 1.0f;
                if (gk == 0) { g.A = XB; g.Bt = (const bf16_t*)(ws + OFF_WGU + m * SZ_WGU); g.M = NTOK; g.N = 2 * FF; g.K = DM; E.mode = 0; }
                else if (gk == 1) { g.A = HU; g.Bt = (const bf16_t*)(ws + OFF_WD + m * SZ_WD); g.M = NTOK; g.N = DM; g.K = FF; E.mode = 1; E.res = p.x; E.resb = (l == 0 && st == 1) ? (const bf16_t*)nullptr : XB; E.scale = 0.5f; }
                else if (gk == 2) { g.A = MEMB; g.Bt = (const bf16_t*)(ws + OFF_WKV + l * SZ_WKV); g.M = 2048; g.N = 1024; g.K = DM; E.mode = 2; E.O = MEMKV; E.ldc = 1024; E.nstore = 4; }
                else if (gk == 3) { g.A = XB; g.Bt = (const bf16_t*)(ws + (l == 0 ? OFF_WIN0 : OFF_WIN1)); g.M = NTOK; g.N = (l == 0 ? LDU0 : NIN1P); g.K = DM; E.mode = 2; E.ldc = (l == 0 ? LDU0 : LDU1); E.nstore = (l == 0 ? 10 : 13); E.gate_pn = (l == 0 ? -1 : 13); }
                else { g.A = XB; g.Bt = (const bf16_t*)(ws + OFF_WOUT + l * SZ_WOUT); g.M = NTOK; g.N = DM; g.K = DM; E.mode = 1; }
                pg8::StaticOrder S; S.init(g.M, g.N, (int)gridDim.x, (int)blockIdx.x);
                pg8::gemm_phase<EpiAll, pg8::StaticOrder, PG8_ALIGN, PG8_SP2>(lds, g, S, E);
#endif
            } else if (st == 2 || st == 10 || st == 13) {
                const int kind = st == 2 ? 0 : (st == 10 ? 1 : 2);
#ifndef NO_LN
                ln_phase(X, X, XB, p.ln_g + (size_t)(l * 3 + kind) * DM, p.ln_b + (size_t)(l * 3 + kind) * DM, kind == 0 || (l == 1 && kind == 2), !(l == 1 && kind == 2), gw, ngw, lane);
#endif
            } else if (st == 5) {
                if (l == 0) {
#ifndef NO_MIX0
                    conv_phase(HU, p.convw, XB, gtid, nthr);
                    xattn_phase(lds, HU, LDU0, 2304, MEMKV, XB, tid);
#endif
                } else {
#ifndef NO_M0
                    m0_phase(GATES, p.bgates, GB, GLI, GM, gw, ngw, lane);
                    xattn_phase(lds, HU, LDU1, 3072, MEMKV, XB, tid);
#endif
                }
            } else if (st == 6) {
#ifndef NO_M1
                m1_phase(lds, HU, p.qkconvw, GB, GLI, GM, GM, CBUF, NBUF, tid);
#endif
            } else if (st == 7) {
#ifndef NO_M2
                m2_phase(CBUF, NBUF, GM, tid);
#endif
            } else {
#ifndef NO_M3
                m3_phase(lds, HU, p.qkconvw, p.hng, GB, GLI, GM, CBUF, NBUF, XB, tid);
#endif
            }
            if (st != 3 && !(l == 1 && st == 13)) GRID_SYNC();
        }
    }
}

#undef GRID_SYNC
#undef tid
#undef wave
#undef lane
#undef gw
#undef ngw
#undef gtid
#undef nthr
extern "C" void kernel_launch(void* const* d_in, const int* in_sizes, int n_in, void* d_out, int out_size, void* d_ws, size_t ws_size, hipStream_t stream) {
    static int grid_blocks = 0;
    if (grid_blocks == 0) {
        if (n_in != 15 || ws_size < WS_END) { fprintf(stderr, "kernel_launch: unexpected n_in %d or workspace %zu < %zu\n", n_in, ws_size, (size_t)WS_END); grid_blocks = -1; return; }
        int dev = 0, cus = 0, per_cu = 0;
        hipGetDevice(&dev);
        hipDeviceGetAttribute(&cus, hipDeviceAttributeMultiprocessorCount, dev);
        if (hipFuncSetAttribute((const void*)fwd_kernel, hipFuncAttributeMaxDynamicSharedMemorySize, LDS_BYTES) != hipSuccess) fprintf(stderr, "kernel_launch: hipFuncSetAttribute failed\n");
        if (hipOccupancyMaxActiveBlocksPerMultiprocessor(&per_cu, (const void*)fwd_kernel, 512, LDS_BYTES) != hipSuccess || per_cu < 1) { per_cu = 1; (void)hipGetLastError(); }
        grid_blocks = cus * 1;
        (void)per_cu;
    }
    if (grid_blocks < 0) return;
    Params p{};
    p.x = (const float*)d_in[0]; p.mem = (const float*)d_in[1]; p.ln_g = (const float*)d_in[2]; p.ln_b = (const float*)d_in[3];
    p.wg = (const float*)d_in[4]; p.wu = (const float*)d_in[5]; p.wd = (const float*)d_in[6]; p.wkv = (const float*)d_in[7]; p.wout = (const float*)d_in[8];
    p.win0 = (const float*)d_in[9]; p.convw = (const float*)d_in[10]; p.win1 = (const float*)d_in[11]; p.bgates = (const float*)d_in[12];
    p.qkconvw = (const float*)d_in[13]; p.hng = (const float*)d_in[14];
    p.out = (float*)d_out; p.ws = (unsigned char*)d_ws;
    if (hipMemsetAsync((unsigned char*)d_ws + OFF_BAR, 0, (size_t)3456 * 4, stream) != hipSuccess) fprintf(stderr, "kernel_launch: hipMemsetAsync failed\n");
    void* args[] = {&p};
    hipError_t e = hipLaunchCooperativeKernel((const void*)fwd_kernel, dim3(grid_blocks), dim3(512), args, LDS_BYTES, stream);
    if (e != hipSuccess) fprintf(stderr, "kernel_launch: cooperative launch failed: %s (grid %d)\n", hipGetErrorString(e), grid_blocks);
}
```

```cpp
#include <hip/hip_runtime.h>
#include <hip/hip_cooperative_groups.h>
#include <cstdio>
#include <cstdint>
namespace cg = cooperative_groups;
namespace pg8 {
#define PG8_LAS __attribute__((address_space(3)))
typedef unsigned short bf16_t;
typedef short bf16x8 __attribute__((ext_vector_type(8)));
typedef float f32x4 __attribute__((ext_vector_type(4)));
typedef unsigned u32x4 __attribute__((ext_vector_type(4)));
constexpr int BM = 256, BK = 64, HALF = 128, HTB = HALF * BK * 2  , STAGE_BYTES = 8 * HTB, NXCD = 8, WGM = 8;

__host__ __device__ __forceinline__ int lds_byte(int r, int c) { const int st = (r >> 4) * 2 + (c >> 5), rr = r & 15, cc = c & 31, ob = rr * 64 + cc * 2; return st * 1024 + (ob ^ (((ob >> 9) & 1) << 5)); }
__host__ __device__ __forceinline__ void stage_rc(int b, int& R, int& C) { const int st = b / 1024, sb = b % 1024, swz = sb ^ (((sb >> 9) & 1) << 5); R = (st >> 1) * 16 + swz / 64; C = (st & 1) * 32 + (swz % 64) / 2; }
__host__ __device__ __forceinline__ int perm32(int rho) { const int n = rho >> 4, i = rho & 15; return 8 * (i >> 2) + 4 * n + (i & 3); }

struct Unit { int pm, pn; };
struct Gemm { const bf16_t* A; const bf16_t* Bt; int M, N, K; };

struct StaticOrder {
    int nM, nN, nwg, G, c;
    __host__ __device__ void init(int M, int N, int G_, int c_) { nM = M / BM; nN = N / BM; nwg = nM * nN; G = G_; c = c_; }
    __host__ __device__ bool next(int i, Unit& u) const {
        const long L = (long)i * G + c; if (L >= nwg) return false;
        int wgid = (int)L; { const int q = nwg / NXCD, r = nwg % NXCD, xcd = wgid % NXCD, off = wgid / NXCD; wgid = (xcd < r ? xcd * (q + 1) : r * (q + 1) + (xcd - r) * q) + off; }
        const int nig = WGM * nN, gid = wgid / nig, fm = gid * WGM, gsz = (nM - fm) < WGM ? (nM - fm) : WGM;
        u.pm = fm + ((wgid % nig) % gsz); u.pn = (wgid % nig) / gsz; return true;
    }
    __device__ __forceinline__ void a_ready(const Unit&) const {}
    __device__ __forceinline__ void done(const Unit&) const {}
};
__device__ __forceinline__ unsigned cvt_pk_bf16(float lo, float hi) { unsigned r; asm volatile("v_cvt_pk_bf16_f32 %0, %1, %2" : "=v"(r) : "v"(lo), "v"(hi)); return r; }
typedef float f32x2 __attribute__((ext_vector_type(2)));
template <class Epi, class Sched, bool ALIGN_EPI = false, bool SP2 = false>
__device__ __forceinline__ void gemm_phase(PG8_LAS unsigned char* lds, const Gemm g, const Sched& S, const Epi& E) {
    int tid_ = threadIdx.x; asm volatile("" : "+v"(tid_));
    const int tid = tid_, wid = __builtin_amdgcn_readfirstlane(tid >> 6), lane = tid & 63, wr = wid >> 2, wc = wid & 3, fr = lane & 15, fq = lane >> 4;
    const int K = g.K, nt = K / BK;
    unsigned voffA[2], voffB[2];
#pragma unroll
    for (int i = 0; i < 2; ++i) { int R, C; stage_rc(tid * 16 + i * 8192, R, C); const int Rb = Epi::PERM ? ((R & ~31) + perm32(R & 31)) : R;
        voffA[i] = (unsigned)(R * K + C) * 2u; voffB[i] = (unsigned)(Rb * K + C) * 2u; }
    const size_t kstep = (size_t)(BK * 2);
    const size_t hstep = (size_t)HALF * K * 2;
    const size_t tstep = 2 * hstep;
    const unsigned ldsw = (unsigned)wid * 1024u;
    const int aoff = lds_byte(wr * 64 + fr, fq * 8), boff = lds_byte(wc * 32 + fr, fq * 8);
#define PG8_SA(b, h) (((b) * 2 + (h)) * HTB)
#define PG8_SB(b, h) ((4 + (b) * 2 + (h)) * HTB)
#define PG8_STAGE(bufoff, gbase, voff) do { _Pragma("unroll") for (int _i = 0; _i < 2; ++_i) \
        __builtin_amdgcn_global_load_lds((const unsigned*)((const char*)(gbase) + (voff)[_i]), (PG8_LAS unsigned*)(lds + (bufoff) + ldsw + _i * 8192), 16, 0, 0); } while (0)
#define PG8_LDA(dst, b, h) do { _Pragma("unroll") for (int m = 0; m < 4; ++m) _Pragma("unroll") for (int k = 0; k < 2; ++k) dst[m][k] = *(const PG8_LAS bf16x8*)(lds + PG8_SA(b, h) + aoff + m * 2048 + k * 1024); } while (0)
#define PG8_LDB(dst, b, h) do { _Pragma("unroll") for (int n = 0; n < 2; ++n) _Pragma("unroll") for (int k = 0; k < 2; ++k) dst[n][k] = *(const PG8_LAS bf16x8*)(lds + PG8_SB(b, h) + boff + n * 2048 + k * 1024); } while (0)
#define PG8_MMA(ai, bj, At, Bt) do { __builtin_amdgcn_s_setprio(1); _Pragma("unroll") for (int m = 0; m < 4; ++m) _Pragma("unroll") for (int n = 0; n < 2; ++n) _Pragma("unroll") for (int k = 0; k < 2; ++k) \
        acc[ai][bj][m][n] = __builtin_amdgcn_mfma_f32_16x16x32_bf16(Bt[n][k], At[m][k], acc[ai][bj][m][n], 0, 0, 0); __builtin_amdgcn_s_setprio(0); } while (0)
#define PG8_WAIT_V(n) asm volatile("s_waitcnt vmcnt(" #n ")" ::: "memory")
#define PG8_WAIT_L(n) asm volatile("s_waitcnt lgkmcnt(" #n ")" ::: "memory")
#define PG8_BAR __builtin_amdgcn_s_barrier()
#define PG8_SCHED __builtin_amdgcn_sched_barrier(0)
    Unit cur, nxt; int ui = 0;
    if (!S.next(0, cur)) return;
    f32x4 acc[2][2][4][2];
#pragma unroll
    for (int a = 0; a < 2; ++a)
#pragma unroll
        for (int b = 0; b < 2; ++b)
#pragma unroll
            for (int m = 0; m < 4; ++m)
#pragma unroll
                for (int n = 0; n < 2; ++n) acc[a][b][m][n] = (f32x4){0.f, 0.f, 0.f, 0.f};
    bf16x8 At[4][2], B0[2][2], B1[2][2];
    const char* cA = (const char*)g.A + (size_t)cur.pm * tstep; const char* cB = (const char*)g.Bt + (size_t)cur.pn * tstep;
    S.a_ready(cur);
    if constexpr (SP2) {
        PG8_STAGE(PG8_SB(0, 0), cB, voffB); PG8_STAGE(PG8_SB(0, 1), cB + hstep, voffB); PG8_STAGE(PG8_SA(0, 0), cA, voffA); PG8_STAGE(PG8_SA(0, 1), cA + hstep, voffA);
        if (wr == 1) PG8_BAR;
        PG8_WAIT_V(2); PG8_BAR;
        PG8_STAGE(PG8_SB(1, 0), cB + kstep, voffB); PG8_STAGE(PG8_SA(1, 0), cA + kstep, voffA); PG8_STAGE(PG8_SB(1, 1), cB + hstep + kstep, voffB);
        PG8_WAIT_V(6); PG8_BAR;
    } else {
        PG8_STAGE(PG8_SB(0, 0), cB, voffB); PG8_STAGE(PG8_SA(0, 0), cA, voffA); PG8_STAGE(PG8_SB(0, 1), cB + hstep, voffB); PG8_STAGE(PG8_SA(0, 1), cA + hstep, voffA);
        if (wr == 1) PG8_BAR;
        PG8_WAIT_V(4); PG8_BAR;
        PG8_STAGE(PG8_SB(1, 0), cB + kstep, voffB); PG8_STAGE(PG8_SA(1, 0), cA + kstep, voffA); PG8_STAGE(PG8_SB(1, 1), cB + hstep + kstep, voffB);
        PG8_WAIT_V(6); PG8_BAR;
    }
    for (;;) {
        const bool has_next = S.next(ui + 1, nxt);
        const char* nA = has_next ? (const char*)g.A + (size_t)nxt.pm * tstep : cA; const char* nB = has_next ? (const char*)g.Bt + (size_t)nxt.pn * tstep : cB;
        for (int t = 0; t < nt; t += 2) {
            const bool last = (t == nt - 2);
            const char* a1 = cA + (size_t)(t + 1) * kstep;
            const char* a2 = last ? nA : cA + (size_t)(t + 2) * kstep; const char* b2 = last ? nB : cB + (size_t)(t + 2) * kstep;
            const char* a3 = a2 + kstep; const char* b3 = b2 + kstep;
            if (last && has_next) S.a_ready(nxt);
            if constexpr (SP2) {
            PG8_LDB(B0, 0, 0); PG8_LDB(B1, 0, 1); PG8_SCHED; PG8_LDA(At, 0, 0); PG8_STAGE(PG8_SA(1, 1), a1 + hstep, voffA);
            PG8_WAIT_V(8); PG8_WAIT_L(0); PG8_BAR; PG8_MMA(0, 0, At, B0); PG8_MMA(0, 1, At, B1); PG8_BAR; PG8_SCHED;
            PG8_LDA(At, 0, 1); PG8_STAGE(PG8_SB(0, 0), b2, voffB); PG8_STAGE(PG8_SB(0, 1), b2 + hstep, voffB); PG8_STAGE(PG8_SA(0, 0), a2, voffA);
            PG8_WAIT_V(8); PG8_WAIT_L(0); PG8_BAR; PG8_MMA(1, 0, At, B0); PG8_MMA(1, 1, At, B1); PG8_BAR; PG8_SCHED;
            PG8_LDB(B0, 1, 0); PG8_LDB(B1, 1, 1); PG8_SCHED; PG8_LDA(At, 1, 0); PG8_STAGE(PG8_SA(0, 1), a2 + hstep, voffA);
            PG8_WAIT_V(8); PG8_WAIT_L(0); PG8_BAR; PG8_MMA(0, 0, At, B0); PG8_MMA(0, 1, At, B1); PG8_BAR; PG8_SCHED;
            PG8_LDA(At, 1, 1); PG8_STAGE(PG8_SB(1, 0), b3, voffB); PG8_STAGE(PG8_SB(1, 1), b3 + hstep, voffB); PG8_STAGE(PG8_SA(1, 0), a3, voffA);
            PG8_WAIT_V(8); PG8_WAIT_L(0); PG8_BAR; PG8_MMA(1, 0, At, B0); PG8_MMA(1, 1, At, B1); PG8_BAR; PG8_SCHED;
            } else {
            PG8_LDB(B0, 0, 0); PG8_SCHED; PG8_LDA(At, 0, 0); PG8_STAGE(PG8_SA(1, 1), a1 + hstep, voffA);
            PG8_WAIT_L(8); PG8_BAR; PG8_WAIT_L(0); PG8_MMA(0, 0, At, B0); PG8_BAR; PG8_SCHED;
            PG8_LDB(B1, 0, 1); PG8_STAGE(PG8_SB(0, 0), b2, voffB);
            PG8_BAR; PG8_WAIT_L(0); PG8_MMA(0, 1, At, B1); PG8_BAR;
            PG8_LDA(At, 0, 1); PG8_STAGE(PG8_SA(0, 0), a2, voffA);
            PG8_BAR; PG8_WAIT_L(0); PG8_MMA(1, 0, At, B0); PG8_BAR; PG8_SCHED;
            PG8_STAGE(PG8_SB(0, 1), b2 + hstep, voffB);
            PG8_WAIT_V(6); PG8_BAR; PG8_MMA(1, 1, At, B1); PG8_BAR;
            PG8_LDB(B0, 1, 0); PG8_SCHED; PG8_LDA(At, 1, 0); PG8_STAGE(PG8_SA(0, 1), a2 + hstep, voffA);
            PG8_WAIT_L(8); PG8_BAR; PG8_WAIT_L(0); PG8_MMA(0, 0, At, B0); PG8_BAR; PG8_SCHED;
            PG8_LDB(B1, 1, 1); PG8_STAGE(PG8_SB(1, 0), b3, voffB);
            PG8_BAR; PG8_WAIT_L(0); PG8_MMA(0, 1, At, B1); PG8_BAR;
            PG8_LDA(At, 1, 1); PG8_STAGE(PG8_SA(1, 0), a3, voffA);
            PG8_BAR; PG8_WAIT_L(0); PG8_MMA(1, 0, At, B0); PG8_BAR; PG8_SCHED;
            PG8_STAGE(PG8_SB(1, 1), b3 + hstep, voffB);
            PG8_WAIT_V(6); PG8_BAR; PG8_MMA(1, 1, At, B1); PG8_BAR;
            }
        }
        if constexpr (ALIGN_EPI) { if (wr == 0) PG8_BAR; }
        if constexpr (!Epi::AFTER_DRAIN) { E(acc, cur, wr, wc, fr, fq); S.done(cur); }
        if (!has_next) break;
#pragma unroll
        for (int a = 0; a < 2; ++a)
#pragma unroll
            for (int b = 0; b < 2; ++b)
#pragma unroll
                for (int m = 0; m < 4; ++m)
#pragma unroll
                    for (int n = 0; n < 2; ++n) acc[a][b][m][n] = (f32x4){0.f, 0.f, 0.f, 0.f};
        cur = nxt; cA = nA; cB = nB; ++ui;
        if constexpr (ALIGN_EPI) { if (wr == 1) PG8_BAR; }
    }
    PG8_WAIT_V(0);
    if constexpr (!ALIGN_EPI) { if (wr == 0) PG8_BAR; }
    PG8_BAR;
    if constexpr (Epi::AFTER_DRAIN) { E.fused(acc, cur, wr, wc, fr, fq, lds, wid, lane); S.done(cur); }
#undef PG8_SA
#undef PG8_SB
#undef PG8_STAGE
#undef PG8_LDA
#undef PG8_LDB
#undef PG8_MMA
#undef PG8_WAIT_V
#undef PG8_WAIT_L
#undef PG8_BAR
#undef PG8_SCHED
}
}

using pg8::bf16_t; using pg8::bf16x8; using pg8::f32x4; using pg8::u32x4; using pg8::Unit;
#define LAS __attribute__((address_space(3)))
typedef unsigned u32x2 __attribute__((ext_vector_type(2)));

constexpr int NTOK = 32768, DM = 1024, FF = 2816, SEQ = 4096;
constexpr int LDU0 = 2560, LDU1 = 3328, NIN1P = 3584, NS1 = 3336;
constexpr float LN_EPS = 1e-5f, ALPHA = 1.41421356237f, RS192 = 0.07216878364870322f;
constexpr int LDS_MAIN = 158720, LDS_BYTES = LDS_MAIN + 16;
#ifndef PG8_SP2
#define PG8_SP2 true
#endif
#ifndef PG8_ALIGN
#define PG8_ALIGN true
#endif
#ifndef DUP_ST
#define DUP_ST (-1)
#endif
#ifndef DUP_L
#define DUP_L (-1)
#endif
#ifndef EXTRA_SYNC
#define EXTRA_SYNC 0
#endif
#ifndef DUP_PRO
#define DUP_PRO 0
#endif
#ifndef DUP_LN
#define DUP_LN 0
#endif

constexpr size_t SZ_WGU = (size_t)5632 * 1024 * 2, SZ_WD = (size_t)1024 * 2816 * 2, SZ_WKV = (size_t)512 * 1024 * 2, SZ_WOUT = (size_t)1024 * 1024 * 2;
constexpr size_t OFF_WGU = 0;
constexpr size_t OFF_WD = OFF_WGU + 4 * SZ_WGU;
constexpr size_t OFF_WKV = OFF_WD + 4 * SZ_WD;
constexpr size_t OFF_WOUT = OFF_WKV + 2 * SZ_WKV;
constexpr size_t OFF_WIN0 = OFF_WOUT + 2 * SZ_WOUT;
constexpr size_t OFF_WIN1 = OFF_WIN0 + (size_t)2560 * 1024 * 2;
constexpr size_t OFF_XB = OFF_WIN1 + (size_t)NIN1P * 1024 * 2;
constexpr size_t OFF_HU = OFF_XB + (size_t)NTOK * 1024 * 2;
constexpr size_t OFF_CBUF = OFF_HU + (size_t)NTOK * LDU1 * 2;
constexpr size_t OFF_MEMB = OFF_CBUF + (size_t)2048 * 36864 * 2;
constexpr size_t OFF_MEMKV = OFF_MEMB + (size_t)2048 * 1024 * 2;
constexpr size_t OFF_GATES = OFF_MEMKV + (size_t)2 * 2048 * 512 * 2;
constexpr size_t OFF_NBUF = OFF_GATES + (size_t)NTOK * 8 * 4;
constexpr size_t OFF_GB = OFF_NBUF + (size_t)2048 * 192 * 4;
constexpr size_t OFF_GLI = OFF_GB + (size_t)32 * 4096 * 4;
constexpr size_t OFF_GM = OFF_GLI + (size_t)32 * 4096 * 4;
constexpr size_t OFF_BAR = OFF_GM + (size_t)5 * 2048 * 4;
constexpr size_t WS_END = OFF_BAR + (size_t)3456 * 4;

struct Params {
    const float *x, *mem, *ln_g, *ln_b, *wg, *wu, *wd, *wkv, *wout, *win0, *convw, *win1, *bgates, *qkconvw, *hng;
    float* out; unsigned char* ws;
};

__device__ __forceinline__ float bf2f(unsigned b) { return __uint_as_float(b << 16); }
__device__ __forceinline__ unsigned f2bf(float f) { unsigned u = __float_as_uint(f); u += 0x7FFFu + ((u >> 16) & 1u); return u >> 16; }
__device__ __forceinline__ unsigned pk2(float lo, float hi) { return f2bf(lo) | (f2bf(hi) << 16); }
__device__ __forceinline__ float silu_f(float v) { return v * __builtin_amdgcn_rcpf(1.0f + __expf(-v)); }
__device__ __forceinline__ float sigmoid_f(float v) { return __builtin_amdgcn_rcpf(1.0f + __expf(-v)); }
__device__ __forceinline__ float wsum(float v) {
#pragma unroll
    for (int o = 1; o < 64; o <<= 1) v += __shfl_xor(v, o);
    return v;
}
__device__ __forceinline__ float wmax(float v) {
#pragma unroll
    for (int o = 1; o < 64; o <<= 1) v = fmaxf(v, __shfl_xor(v, o));
    return v;
}
#define LO16(w) bf2f((w) & 0xffffu)
#define HI16(w) __uint_as_float((w) & 0xffff0000u)
#define MFMA16(a, b, c) __builtin_amdgcn_mfma_f32_16x16x32_bf16((a), (b), (c), 0, 0, 0)

struct EpiSwiglu {
    static constexpr bool PERM = true, AFTER_DRAIN = false;
    bf16_t* H;
    __device__ __forceinline__ void operator()(const f32x4 (&acc)[2][2][4][2], const Unit& u, int wr, int wc, int fr, int fq) const {
        const int row0 = u.pm * 256 + wr * 64 + fr, col0 = u.pn * 128 + wc * 32 + 8 * fq;
#pragma unroll
        for (int ai = 0; ai < 2; ++ai)
#pragma unroll
            for (int m = 0; m < 4; ++m) {
                bf16_t* rowp = H + (size_t)(row0 + ai * 128 + m * 16) * FF + col0;
                const f32x4 g0 = acc[ai][0][m][0], g1 = acc[ai][0][m][1], u0 = acc[ai][1][m][0], u1 = acc[ai][1][m][1];
                u32x4 w;
                w.x = pg8::cvt_pk_bf16(silu_f(g0[0]) * u0[0], silu_f(g0[1]) * u0[1]);
                w.y = pg8::cvt_pk_bf16(silu_f(g0[2]) * u0[2], silu_f(g0[3]) * u0[3]);
                w.z = pg8::cvt_pk_bf16(silu_f(g1[0]) * u1[0], silu_f(g1[1]) * u1[1]);
                w.w = pg8::cvt_pk_bf16(silu_f(g1[2]) * u1[2], silu_f(g1[3]) * u1[3]);
                *(u32x4*)rowp = w;
            }
    }
};
struct EpiRes {
    static constexpr bool PERM = false, AFTER_DRAIN = false;
    const float* res; float* out; float scale;
    __device__ __forceinline__ void operator()(const f32x4 (&acc)[2][2][4][2], const Unit& u, int wr, int wc, int fr, int fq) const {
        const int row0 = u.pm * 256 + wr * 64 + fr, col0 = u.pn * 256 + wc * 32 + 4 * fq;
#pragma unroll
        for (int ai = 0; ai < 2; ++ai)
#pragma unroll
            for (int m = 0; m < 4; ++m) {
                const size_t off = (size_t)(row0 + ai * 128 + m * 16) * DM + col0;
#pragma unroll
                for (int bj = 0; bj < 2; ++bj)
#pragma unroll
                    for (int n = 0; n < 2; ++n) {
                        const f32x4 r = *(const f32x4*)(res + off + bj * 128 + n * 16);
                        *(f32x4*)(out + off + bj * 128 + n * 16) = r * ALPHA + acc[ai][bj][m][n] * scale;
                    }
                asm volatile("" ::: "memory");
            }
    }
};
struct EpiU {
    static constexpr bool PERM = true, AFTER_DRAIN = false;
    bf16_t* O; int ldc; int nstore; float* gates; int gate_pn;
    __device__ __forceinline__ void operator()(const f32x4 (&acc)[2][2][4][2], const Unit& u, int wr, int wc, int fr, int fq) const {
        const int row0 = u.pm * 256 + wr * 64 + fr;
        if (u.pn < nstore) {
            const int col0 = u.pn * 256 + wc * 32 + 8 * fq;
#pragma unroll
            for (int ai = 0; ai < 2; ++ai)
#pragma unroll
                for (int m = 0; m < 4; ++m) {
                    bf16_t* rowp = O + (size_t)(row0 + ai * 128 + m * 16) * ldc + col0;
#pragma unroll
                    for (int bj = 0; bj < 2; ++bj) {
                        const f32x4 v0 = acc[ai][bj][m][0], v1 = acc[ai][bj][m][1];
                        u32x4 w; w.x = pg8::cvt_pk_bf16(v0[0], v0[1]); w.y = pg8::cvt_pk_bf16(v0[2], v0[3]); w.z = pg8::cvt_pk_bf16(v1[0], v1[1]); w.w = pg8::cvt_pk_bf16(v1[2], v1[3]);
                        *(u32x4*)(rowp + bj * 128) = w;
                    }
                }
        } else if (u.pn == gate_pn) {
            if (wc == 0 && fq == 0) {
#pragma unroll
                for (int ai = 0; ai < 2; ++ai)
#pragma unroll
                    for (int m = 0; m < 4; ++m) {
                        float* gp = gates + (size_t)(row0 + ai * 128 + m * 16) * 8;
                        *(f32x4*)gp = acc[ai][0][m][0]; *(f32x4*)(gp + 4) = acc[ai][0][m][1];
                    }
            }
        }
    }
};

struct EpiAll {
    static constexpr bool PERM = true, AFTER_DRAIN = false;
    int mode; bf16_t* O; int ldc; int nstore; float* gates; int gate_pn; const float* res; const bf16_t* resb; float* out; float scale;
    __device__ __forceinline__ void operator()(const f32x4 (&acc)[2][2][4][2], const Unit& u, int wr, int wc, int fr, int fq) const {
        const int row0 = u.pm * 256 + wr * 64 + fr;
        if (mode == 0) {
            const int col0 = u.pn * 128 + wc * 32 + 8 * fq;
#pragma unroll
            for (int ai = 0; ai < 2; ++ai)
#pragma unroll
                for (int m = 0; m < 4; ++m) {
                    bf16_t* rowp = O + (size_t)(row0 + ai * 128 + m * 16) * FF + col0;
                    const f32x4 g0 = acc[ai][0][m][0], g1 = acc[ai][0][m][1], u0 = acc[ai][1][m][0], u1 = acc[ai][1][m][1];
                    u32x4 w;
                    w.x = pg8::cvt_pk_bf16(silu_f(g0[0]) * u0[0], silu_f(g0[1]) * u0[1]);
                    w.y = pg8::cvt_pk_bf16(silu_f(g0[2]) * u0[2], silu_f(g0[3]) * u0[3]);
                    w.z = pg8::cvt_pk_bf16(silu_f(g1[0]) * u1[0], silu_f(g1[1]) * u1[1]);
                    w.w = pg8::cvt_pk_bf16(silu_f(g1[2]) * u1[2], silu_f(g1[3]) * u1[3]);
                    *(u32x4*)rowp = w;
                }
        } else if (mode == 1) {
            const int col0 = u.pn * 256 + wc * 32 + 8 * fq;
#pragma unroll
            for (int ai = 0; ai < 2; ++ai)
#pragma unroll
                for (int m = 0; m < 4; ++m) {
                    const size_t off = (size_t)(row0 + ai * 128 + m * 16) * DM + col0;
#pragma unroll
                    for (int bj = 0; bj < 2; ++bj) {
                        f32x4 r0, r1;
                        if (resb) { const u32x4 rb = *(const u32x4*)(resb + off + bj * 128); r0 = (f32x4){LO16(rb.x), HI16(rb.x), LO16(rb.y), HI16(rb.y)}; r1 = (f32x4){LO16(rb.z), HI16(rb.z), LO16(rb.w), HI16(rb.w)}; }
                        else { r0 = *(const f32x4*)(res + off + bj * 128); r1 = *(const f32x4*)(res + off + bj * 128 + 4); }
                        *(f32x4*)(out + off + bj * 128) = r0 * ALPHA + acc[ai][bj][m][0] * scale;
                        *(f32x4*)(out + off + bj * 128 + 4) = r1 * ALPHA + acc[ai][bj][m][1] * scale;
                    }
                    if (m == 3 && !resb) asm volatile("" ::: "memory");
                }
        } else {
            if (u.pn < nstore) {
                const int col0 = u.pn * 256 + wc * 32 + 8 * fq;
#pragma unroll
                for (int ai = 0; ai < 2; ++ai)
#pragma unroll
                    for (int m = 0; m < 4; ++m) {
                        bf16_t* rowp = O + (size_t)(row0 + ai * 128 + m * 16) * ldc + col0;
#pragma unroll
                        for (int bj = 0; bj < 2; ++bj) {
                            const f32x4 v0 = acc[ai][bj][m][0], v1 = acc[ai][bj][m][1];
                            u32x4 w; w.x = pg8::cvt_pk_bf16(v0[0], v0[1]); w.y = pg8::cvt_pk_bf16(v0[2], v0[3]); w.z = pg8::cvt_pk_bf16(v1[0], v1[1]); w.w = pg8::cvt_pk_bf16(v1[2], v1[3]);
                            *(u32x4*)(rowp + bj * 128) = w;
                        }
                    }
            } else if (u.pn == gate_pn) {
                if (wc == 0 && fq == 0) {
#pragma unroll
                    for (int ai = 0; ai < 2; ++ai)
#pragma unroll
                        for (int m = 0; m < 4; ++m) {
                            float* gp = gates + (size_t)(row0 + ai * 128 + m * 16) * 8;
                            *(f32x4*)gp = acc[ai][0][m][0]; *(f32x4*)(gp + 4) = acc[ai][0][m][1];
                        }
                }
            }
        }
    }
};

__device__ __forceinline__ void tr_item(const float* colp4, int Ns, bf16_t* WT, int K, int r0, int k0, LAS float* scr, int lane) {
    f32x4 v[8];
#pragma unroll
    for (int i = 0; i < 8; ++i) { const int kk = (lane >> 3) + 8 * i; v[i] = colp4 ? *(const f32x4*)(colp4 + (size_t)(k0 + kk) * Ns) : (f32x4){0.f, 0.f, 0.f, 0.f}; }
#pragma unroll
    for (int i = 0; i < 8; ++i) { const int kk = (lane >> 3) + 8 * i; LAS float* d = scr + kk * 33 + 4 * (lane & 7); d[0] = v[i][0]; d[1] = v[i][1]; d[2] = v[i][2]; d[3] = v[i][3]; }
    asm volatile("s_waitcnt lgkmcnt(0)" ::: "memory");
    const int c = lane & 7;
#pragma unroll
    for (int j = 0; j < 4; ++j) { const int n = (lane >> 3) + 8 * j; const LAS float* s = scr + (8 * c) * 33 + n;
        u32x4 o; o.x = pk2(s[0], s[33]); o.y = pk2(s[2 * 33], s[3 * 33]); o.z = pk2(s[4 * 33], s[5 * 33]); o.w = pk2(s[6 * 33], s[7 * 33]);
        *(u32x4*)(WT + (size_t)(r0 + n) * K + k0 + 8 * c) = o; }
    asm volatile("s_waitcnt lgkmcnt(0)" ::: "memory");
}
__device__ __forceinline__ void cvt_rows(const float* src, bf16_t* dst, size_t n8, size_t gtid, size_t nthr) {
    for (size_t i = gtid; i < n8; i += nthr) { const f32x4 a = *(const f32x4*)(src + i * 8), b = *(const f32x4*)(src + i * 8 + 4);
        u32x4 w; w.x = pk2(a[0], a[1]); w.y = pk2(a[2], a[3]); w.z = pk2(b[0], b[1]); w.w = pk2(b[2], b[3]); *(u32x4*)(dst + i * 8) = w; }
}
__device__ __forceinline__ void prologue(const Params& p, LAS unsigned char* lds, int gw, int ngw, int wave, int lane, size_t gtid, size_t nthr) {
    LAS float* scr = (LAS float*)(lds + wave * 8704);
    unsigned char* ws = p.ws;
    constexpr int I_GU = 176 * 16, I_D = 32 * 44, I_KV = 16 * 16, I_O = 32 * 16, I_0 = 80 * 16, I_1 = 112 * 16;
    constexpr int NITEMS = 4 * I_GU + 4 * I_D + 2 * I_KV + 2 * I_O + I_0 + I_1;
    const int l31 = 4 * (lane & 7);
    for (int it = gw; it < NITEMS; it += ngw) {
        int r = it;
        if (r < 4 * I_GU) { const int m = r / I_GU; r -= m * I_GU; const int kb = r / 176, nb = r % 176, row = nb * 32 + l31, pn = row >> 8, bj = (row >> 7) & 1, j = row & 127;
            tr_item((bj ? p.wu : p.wg) + (size_t)m * 1024 * FF + 128 * pn + j, FF, (bf16_t*)(ws + OFF_WGU + m * SZ_WGU), 1024, nb * 32, kb * 64, scr, lane); continue; }
        r -= 4 * I_GU;
        if (r < 4 * I_D) { const int m = r / I_D; r -= m * I_D; const int kb = r >> 5, nb = r & 31, row = nb * 32 + l31;
            tr_item(p.wd + (size_t)m * FF * 1024 + row, 1024, (bf16_t*)(ws + OFF_WD + m * SZ_WD), FF, nb * 32, kb * 64, scr, lane); continue; }
        r -= 4 * I_D;
        if (r < 2 * I_KV) { const int m = r / I_KV; r -= m * I_KV; const int kb = r >> 4, nb = r & 15, row = nb * 32 + l31;
            tr_item(p.wkv + (size_t)m * 1024 * 512 + row, 512, (bf16_t*)(ws + OFF_WKV + m * SZ_WKV), 1024, nb * 32, kb * 64, scr, lane); continue; }
        r -= 2 * I_KV;
        if (r < 2 * I_O) { const int m = r / I_O; r -= m * I_O; const int kb = r >> 5, nb = r & 31, row = nb * 32 + l31;
            tr_item(p.wout + (size_t)m * 1024 * 1024 + row, 1024, (bf16_t*)(ws + OFF_WOUT + m * SZ_WOUT), 1024, nb * 32, kb * 64, scr, lane); continue; }
        r -= 2 * I_O;
        if (r < I_0) { const int kb = r / 80, nb = r % 80, row = nb * 32 + l31;
            tr_item(p.win0 + row, LDU0, (bf16_t*)(ws + OFF_WIN0), 1024, nb * 32, kb * 64, scr, lane); continue; }
        r -= I_0;
        { const int kb = r / 112, nb = r % 112, row = nb * 32 + l31;
          const int col = row < 3072 ? row : (row < 3328 ? row + 8 : (row < 3336 ? row - 256 : -1));
          tr_item(col >= 0 ? p.win1 + col : (const float*)nullptr, NS1, (bf16_t*)(ws + OFF_WIN1), 1024, nb * 32, kb * 64, scr, lane); }
    }
    cvt_rows(p.x, (bf16_t*)(ws + OFF_XB), (size_t)NTOK * DM / 8, gtid, nthr);
    cvt_rows(p.mem, (bf16_t*)(ws + OFF_MEMB), (size_t)2048 * DM / 8, gtid, nthr);
}

__device__ __forceinline__ void ln_phase(const float* Xin, float* Xout, bf16_t* XB, const float* g, const float* b, bool wf32, bool wbf, int gw, int ngw, int lane) {
    f32x4 gv[4], bv[4];
#pragma unroll
    for (int j = 0; j < 4; ++j) { gv[j] = ((const f32x4*)g)[lane + 64 * j]; bv[j] = ((const f32x4*)b)[lane + 64 * j]; }
    for (int row0 = gw * 4; row0 < NTOK; row0 += ngw * 4) {
        f32x4 v[4][4]; float s[4], s2[4];
#pragma unroll
        for (int r = 0; r < 4; ++r) { const f32x4* xr = (const f32x4*)(Xin + (size_t)(row0 + r) * DM) + lane;
#pragma unroll
            for (int j = 0; j < 4; ++j) v[r][j] = xr[64 * j]; }
#pragma unroll
        for (int r = 0; r < 4; ++r) { s[r] = 0.f;
#pragma unroll
            for (int j = 0; j < 4; ++j) s[r] += (v[r][j][0] + v[r][j][1]) + (v[r][j][2] + v[r][j][3]); }
#pragma unroll
        for (int o = 1; o < 64; o <<= 1)
#pragma unroll
            for (int r = 0; r < 4; ++r) s[r] += __shfl_xor(s[r], o);
#pragma unroll
        for (int r = 0; r < 4; ++r) { const float mean = s[r] * (1.f / DM); s2[r] = 0.f;
#pragma unroll
            for (int j = 0; j < 4; ++j) { v[r][j] = v[r][j] - mean; s2[r] += (v[r][j][0] * v[r][j][0] + v[r][j][1] * v[r][j][1]) + (v[r][j][2] * v[r][j][2] + v[r][j][3] * v[r][j][3]); } }
#pragma unroll
        for (int o = 1; o < 64; o <<= 1)
#pragma unroll
            for (int r = 0; r < 4; ++r) s2[r] += __shfl_xor(s2[r], o);
#pragma unroll
        for (int r = 0; r < 4; ++r) {
            const float rstd = 1.0f / sqrtf(s2[r] * (1.f / DM) + LN_EPS);
            f32x4* xo = (f32x4*)(Xout + (size_t)(row0 + r) * DM) + lane;
            u32x2* bo = (u32x2*)(XB + (size_t)(row0 + r) * DM) + lane;
#pragma unroll
            for (int j = 0; j < 4; ++j) { const f32x4 y = v[r][j] * rstd * gv[j] + bv[j]; if (wf32) xo[64 * j] = y; if (wbf) { u32x2 w; w.x = pk2(y[0], y[1]); w.y = pk2(y[2], y[3]); bo[64 * j] = w; } }
        }
    }
}

__device__ __forceinline__ void conv_phase(const bf16_t* U, const float* cw, bf16_t* MIX, size_t gtid, size_t nthr) {
    for (size_t i = gtid; i < (size_t)NTOK * 96; i += nthr) {
        const int tok = (int)(i / 96), cgi = (int)(i % 96), pos = tok & (SEQ - 1);
        const bf16_t* up = U + (size_t)tok * LDU0 + cgi * 8;
        const u32x4 bg = *(const u32x4*)up;
        float acc[8];
#pragma unroll
        for (int e = 0; e < 8; ++e) acc[e] = 0.f;
#pragma unroll
        for (int j = 0; j < 3; ++j) {
            if (pos - j >= 0) {
                const u32x4 c = *(const u32x4*)(up - (size_t)j * LDU0 + 768), xi = *(const u32x4*)(up - (size_t)j * LDU0 + 1536);
                const f32x4 w0 = *(const f32x4*)(cw + (2 - j) * 768 + cgi * 8), w1 = *(const f32x4*)(cw + (2 - j) * 768 + cgi * 8 + 4);
                acc[0] += w0[0] * LO16(c.x) * LO16(xi.x); acc[1] += w0[1] * HI16(c.x) * HI16(xi.x);
                acc[2] += w0[2] * LO16(c.y) * LO16(xi.y); acc[3] += w0[3] * HI16(c.y) * HI16(xi.y);
                acc[4] += w1[0] * LO16(c.z) * LO16(xi.z); acc[5] += w1[1] * HI16(c.z) * HI16(xi.z);
                acc[6] += w1[2] * LO16(c.w) * LO16(xi.w); acc[7] += w1[3] * HI16(c.w) * HI16(xi.w);
            }
        }
        u32x4 o;
        o.x = pk2(LO16(bg.x) * acc[0], HI16(bg.x) * acc[1]); o.y = pk2(LO16(bg.y) * acc[2], HI16(bg.y) * acc[3]);
        o.z = pk2(LO16(bg.z) * acc[4], HI16(bg.z) * acc[5]); o.w = pk2(LO16(bg.w) * acc[6], HI16(bg.w) * acc[7]);
        *(u32x4*)(MIX + (size_t)tok * DM + cgi * 8) = o;
    }
}

__device__ __forceinline__ void xattn_phase(LAS unsigned char* lds, const bf16_t* U, int ldu, int qoff, const bf16_t* KV, bf16_t* MIX, int tid) {
    const int wave = tid >> 6, lane = tid & 63, fr = lane & 15, fq = lane >> 4;
    LAS bf16_t* Ks = (LAS bf16_t*)lds;
    LAS bf16_t* Vt = Ks + 256 * 72;
    for (int item = blockIdx.x; item < 256; item += gridDim.x) {
        const int b = item >> 5, hd = (item >> 3) & 3, tc = item & 7;
        __syncthreads();
#pragma unroll
        for (int i = 0; i < 4; ++i) {
            const int id = tid + 512 * i, key = id >> 3, dc = id & 7;
            const bf16_t* src = KV + (size_t)(b * 256 + key) * 1024 + hd * 64 + dc * 8;
            const u32x4 kk = *(const u32x4*)src, vv = *(const u32x4*)(src + 256);
            *(LAS u32x4*)(Ks + key * 72 + dc * 8) = kk;
            const int kb = key >> 4, q4 = (key >> 2) & 3, e4 = key & 3, pos = (kb >> 1) * 32 + q4 * 8 + (kb & 1) * 4 + e4;
            LAS bf16_t* vd = Vt + (dc * 8) * 264 + pos;
            vd[0] = (bf16_t)(vv.x & 0xffffu); vd[264] = (bf16_t)(vv.x >> 16); vd[2 * 264] = (bf16_t)(vv.y & 0xffffu); vd[3 * 264] = (bf16_t)(vv.y >> 16);
            vd[4 * 264] = (bf16_t)(vv.z & 0xffffu); vd[5 * 264] = (bf16_t)(vv.z >> 16); vd[6 * 264] = (bf16_t)(vv.w & 0xffffu); vd[7 * 264] = (bf16_t)(vv.w >> 16);
        }
        __syncthreads();
#pragma unroll 1
        for (int tt = 0; tt < 4; ++tt) {
            asm volatile("" ::: "memory");
            const int tok0 = b * SEQ + tc * 512 + (wave * 4 + tt) * 16;
            const bf16_t* qp = U + (size_t)(tok0 + fr) * ldu + qoff + hd * 64 + fq * 8;
            const bf16x8 qf0 = *(const bf16x8*)qp, qf1 = *(const bf16x8*)(qp + 32);
            f32x4 s[16];
#pragma unroll
            for (int kb = 0; kb < 16; ++kb) {
                const LAS bf16_t* kp = Ks + (kb * 16 + fr) * 72 + fq * 8;
                f32x4 a = {0.f, 0.f, 0.f, 0.f};
                a = MFMA16(*(const LAS bf16x8*)kp, qf0, a);
                a = MFMA16(*(const LAS bf16x8*)(kp + 32), qf1, a);
                s[kb] = a;
            }
            float mx = -3.0e38f;
#pragma unroll
            for (int kb = 0; kb < 16; ++kb) mx = fmaxf(mx, fmaxf(fmaxf(s[kb][0], s[kb][1]), fmaxf(s[kb][2], s[kb][3])));
            mx = fmaxf(mx, __shfl_xor(mx, 16)); mx = fmaxf(mx, __shfl_xor(mx, 32));
            const float sc = 0.125f * 1.44269504089f; float sum = 0.f;
#pragma unroll
            for (int kb = 0; kb < 16; ++kb)
#pragma unroll
                for (int j = 0; j < 4; ++j) { const float pe = exp2f((s[kb][j] - mx) * sc); s[kb][j] = pe; sum += pe; }
            sum += __shfl_xor(sum, 16); sum += __shfl_xor(sum, 32);
            const float inv = 1.0f / sum;
            f32x4 o[4];
#pragma unroll
            for (int dn = 0; dn < 4; ++dn) o[dn] = (f32x4){0.f, 0.f, 0.f, 0.f};
#pragma unroll
            for (int ks = 0; ks < 8; ++ks) {
                u32x4 pw; pw.x = pk2(s[2 * ks][0], s[2 * ks][1]); pw.y = pk2(s[2 * ks][2], s[2 * ks][3]); pw.z = pk2(s[2 * ks + 1][0], s[2 * ks + 1][1]); pw.w = pk2(s[2 * ks + 1][2], s[2 * ks + 1][3]);
                const bf16x8 pf = __builtin_bit_cast(bf16x8, pw);
#pragma unroll
                for (int dn = 0; dn < 4; ++dn) o[dn] = MFMA16(*(const LAS bf16x8*)(Vt + (dn * 16 + fr) * 264 + ks * 32 + fq * 8), pf, o[dn]);
            }
            bf16_t* op = MIX + (size_t)(tok0 + fr) * DM + 768 + hd * 64 + fq * 4;
#pragma unroll
            for (int dn = 0; dn < 4; ++dn) { u32x2 w; w.x = pk2(o[dn][0] * inv, o[dn][1] * inv); w.y = pk2(o[dn][2] * inv, o[dn][3] * inv); *(u32x2*)(op + dn * 16) = w; }
        }
    }
}

__device__ __forceinline__ void m0_phase(const float* GATES, const float* bg, float* GB, float* GLI, float* GM, int gw, int ngw, int lane) {
    for (int item = gw; item < 2048; item += ngw) {
        const int bh = item >> 6, c = item & 63, b = bh >> 2, h = bh & 3;
        const size_t tok = (size_t)b * SEQ + c * 64 + lane;
        const float ip = GATES[tok * 8 + h] + bg[h], fp = GATES[tok * 8 + 4 + h] + bg[4 + h];
        const float lf = fminf(fp, 0.f) - log1pf(expf(-fabsf(fp)));
        float bc = lf;
#pragma unroll
        for (int o = 1; o < 64; o <<= 1) { const float t = __shfl_up(bc, o); if (lane >= o) bc += t; }
        const float bl = __shfl(bc, 63);
        const float mxl = wmax(bl - bc + ip);
        GB[(size_t)bh * SEQ + c * 64 + lane] = bc; GLI[(size_t)bh * SEQ + c * 64 + lane] = ip;
        if (lane == 0) { GM[6144 + item] = bl; GM[8192 + item] = mxl; }
    }
}
__device__ __forceinline__ void chunk_stab(const float* GM, int bh, int c, int lane, float& mst_c, float& mnew_c, float& dec_c) {
    const float bl = GM[6144 + bh * 64 + lane], ml = GM[8192 + bh * 64 + lane];
    float B = bl;
#pragma unroll
    for (int o = 1; o < 64; o <<= 1) { const float t = __shfl_up(B, o); if (lane >= o) B += t; }
    float pm = ml - B;
#pragma unroll
    for (int o = 1; o < 64; o <<= 1) { const float t = __shfl_up(pm, o); if (lane >= o) pm = fmaxf(pm, t); }
    const float mnew = B + fmaxf(0.f, pm);
    const float mprev = __shfl_up(mnew, 1);
    const float mst = lane == 0 ? 0.f : mprev;
    const float dec = expf(bl + mst - mnew);
    mst_c = __int_as_float(__builtin_amdgcn_readlane(__float_as_int(mst), c));
    mnew_c = __int_as_float(__builtin_amdgcn_readlane(__float_as_int(mnew), c));
    dec_c = __int_as_float(__builtin_amdgcn_readlane(__float_as_int(dec), c));
}

__device__ __forceinline__ void qk_conv8(const bf16_t* U, const float* qkw, size_t tok, int pos, int col, float (&r)[8]) {
#pragma unroll
    for (int e = 0; e < 8; ++e) r[e] = 0.f;
#pragma unroll
    for (int j = 0; j < 4; ++j) {
        if (pos - j >= 0) {
            const u32x4 v = *(const u32x4*)(U + (tok - j) * LDU1 + col);
            const f32x4 w0 = *(const f32x4*)(qkw + (3 - j) * 1536 + col), w1 = *(const f32x4*)(qkw + (3 - j) * 1536 + col + 4);
            r[0] += w0[0] * LO16(v.x); r[1] += w0[1] * HI16(v.x); r[2] += w0[2] * LO16(v.y); r[3] += w0[3] * HI16(v.y);
            r[4] += w1[0] * LO16(v.z); r[5] += w1[1] * HI16(v.z); r[6] += w1[2] * LO16(v.w); r[7] += w1[3] * HI16(v.w);
        }
    }
#pragma unroll
    for (int e = 0; e < 8; ++e) r[e] = silu_f(r[e]);
}

__device__ __forceinline__ void m1_phase(LAS unsigned char* lds, const bf16_t* U, const float* qkw, const float* GB, const float* GLI, const float* GM, float* GMW, bf16_t* CBUF, float* NBUF, int tid) {
    const int wave = tid >> 6, lane = tid & 63, fr = lane & 15, fq = lane >> 4;
    LAS bf16_t* KT = (LAS bf16_t*)lds;
    LAS bf16_t* VT = KT + 192 * 72;
    for (int item = blockIdx.x; item < 2048; item += gridDim.x) {
        const int bh = item >> 6, c = item & 63, b = bh >> 2, h = bh & 3;
        const size_t tok0 = (size_t)b * SEQ + c * 64;
        __syncthreads();
        {
            const int s = tid & 63, g0 = tid >> 6;
            const size_t gi = (size_t)bh * SEQ + c * 64;
            float mst_c, mnew_c, dec_c; chunk_stab(GM, bh, c, lane, mst_c, mnew_c, dec_c);
            if (tid == 0) { GMW[bh * 64 + c] = mst_c; GMW[2048 + bh * 64 + c] = mnew_c; GMW[4096 + bh * 64 + c] = dec_c; }
            const float wk = __expf(GB[gi + 63] - GB[gi + s] + GLI[gi + s] - mnew_c) * RS192;
#pragma unroll
            for (int it = 0; it < 3; ++it) {
                const int g = g0 + 8 * it, ch = h * 192 + g * 8;
                float kv[8];
                qk_conv8(U, qkw, tok0 + s, c * 64 + s, 768 + ch, kv);
                const u32x4 vv = *(const u32x4*)(U + (tok0 + s) * LDU1 + 1536 + ch);
                LAS bf16_t* kd = KT + (g * 8) * 72 + s; LAS bf16_t* vd = VT + (g * 8) * 72 + s;
#pragma unroll
                for (int e = 0; e < 8; ++e) kd[e * 72] = (bf16_t)f2bf(kv[e] * wk);
                vd[0] = (bf16_t)(vv.x & 0xffffu); vd[72] = (bf16_t)(vv.x >> 16); vd[2 * 72] = (bf16_t)(vv.y & 0xffffu); vd[3 * 72] = (bf16_t)(vv.y >> 16);
                vd[4 * 72] = (bf16_t)(vv.z & 0xffffu); vd[5 * 72] = (bf16_t)(vv.z >> 16); vd[6 * 72] = (bf16_t)(vv.w & 0xffffu); vd[7 * 72] = (bf16_t)(vv.w >> 16);
            }
        }
        __syncthreads();
        if (tid < 192) { float sm = 0.f;
#pragma unroll 8
            for (int s = 0; s < 64; ++s) sm += bf2f(KT[tid * 72 + s]);
            NBUF[(size_t)(bh * 64 + c) * 192 + tid] = sm; }
        bf16_t* cb = CBUF + (size_t)(bh * 64 + c) * 36864;
#pragma unroll 2
        for (int i = 0; i < 18; ++i) {
            const int idx = wave * 18 + i, dkt = idx / 12, dvt = idx % 12;
            const LAS bf16_t* ap = KT + (dkt * 16 + fr) * 72 + fq * 8; const LAS bf16_t* bp = VT + (dvt * 16 + fr) * 72 + fq * 8;
            f32x4 a = {0.f, 0.f, 0.f, 0.f};
            a = MFMA16(*(const LAS bf16x8*)ap, *(const LAS bf16x8*)bp, a);
            a = MFMA16(*(const LAS bf16x8*)(ap + 32), *(const LAS bf16x8*)(bp + 32), a);
            u32x2 w; w.x = pk2(a[0], a[1]); w.y = pk2(a[2], a[3]);
            *(u32x2*)(cb + (size_t)(dvt * 16 + fr) * 192 + dkt * 16 + fq * 4) = w;
        }
    }
}

__device__ __forceinline__ void m2_phase(bf16_t* CBUF, float* NBUF, const float* GM, int tidx) {
    for (int i = (int)blockIdx.x * 288 + tidx; tidx < 288 && i < 32 * 2304; i += (int)gridDim.x * 288) {
        const int bh = i / 2304, e = i % 2304;
        bf16_t* ptr = CBUF + (size_t)bh * 64 * 36864 + e * 16;
        const float* dec = GM + 4096 + bh * 64;
        float r[16];
#pragma unroll
        for (int k = 0; k < 16; ++k) r[k] = 0.f;
#pragma unroll 4
        for (int c = 0; c < 64; ++c) {
            const u32x4 d0 = *(const u32x4*)(ptr + (size_t)c * 36864), d1 = *(const u32x4*)(ptr + (size_t)c * 36864 + 8);
            u32x4 w0, w1;
            w0.x = pk2(r[0], r[1]); w0.y = pk2(r[2], r[3]); w0.z = pk2(r[4], r[5]); w0.w = pk2(r[6], r[7]);
            w1.x = pk2(r[8], r[9]); w1.y = pk2(r[10], r[11]); w1.z = pk2(r[12], r[13]); w1.w = pk2(r[14], r[15]);
            *(u32x4*)(ptr + (size_t)c * 36864) = w0; *(u32x4*)(ptr + (size_t)c * 36864 + 8) = w1;
            const float dc = dec[c];
            r[0] = dc * r[0] + LO16(d0.x); r[1] = dc * r[1] + HI16(d0.x); r[2] = dc * r[2] + LO16(d0.y); r[3] = dc * r[3] + HI16(d0.y);
            r[4] = dc * r[4] + LO16(d0.z); r[5] = dc * r[5] + HI16(d0.z); r[6] = dc * r[6] + LO16(d0.w); r[7] = dc * r[7] + HI16(d0.w);
            r[8] = dc * r[8] + LO16(d1.x); r[9] = dc * r[9] + HI16(d1.x); r[10] = dc * r[10] + LO16(d1.y); r[11] = dc * r[11] + HI16(d1.y);
            r[12] = dc * r[12] + LO16(d1.z); r[13] = dc * r[13] + HI16(d1.z); r[14] = dc * r[14] + LO16(d1.w); r[15] = dc * r[15] + HI16(d1.w);
        }
    }
    if (tidx >= 288 && tidx < 312) {
        for (int i = (int)blockIdx.x * 24 + (tidx - 288); i < 32 * 192; i += (int)gridDim.x * 24) {
            const int bh = i / 192, e = i % 192;
            float* ptr = NBUF + (size_t)bh * 64 * 192 + e;
            const float* dec = GM + 4096 + bh * 64;
            float r = 0.f;
            for (int c = 0; c < 64; ++c) { const float d = ptr[c * 192]; ptr[c * 192] = r; r = dec[c] * r + d; }
        }
    }
}

__device__ __forceinline__ void m3_phase(LAS unsigned char* lds, const bf16_t* U, const float* qkw, const float* hng, const float* GB, const float* GLI, const float* GM,
                                         const bf16_t* CBUF, const float* NBUF, bf16_t* MIX, int tid) {
    const int wave = tid >> 6, lane = tid & 63, fr = lane & 15, fq = lane >> 4;
    LAS bf16_t* Qs = (LAS bf16_t*)lds;
    LAS bf16_t* Ks = (LAS bf16_t*)(lds + 25600);
    LAS bf16_t* VT = (LAS bf16_t*)(lds + 51200);
    LAS bf16_t* CT = (LAS bf16_t*)(lds + 78848);
    LAS float* Hs = (LAS float*)(lds + 78848);
    LAS float* nS = (LAS float*)(lds + 155648);
    LAS float* bcS = nS + 192; LAS float* liS = bcS + 64; LAS float* mtS = liS + 64; LAS float* winS = mtS + 64; LAS float* qnS = winS + 64; LAS float* denP = qnS + 64;
    LAS bf16_t* Ps = Ks;
    for (int item = blockIdx.x; item < 2048; item += gridDim.x) {
        const int bh = item >> 6, c = item & 63, b = bh >> 2, h = bh & 3;
        const size_t tok0 = (size_t)b * SEQ + c * 64;
        __syncthreads();
#ifdef M3_DUP_STAGE
#pragma unroll 1
        for (int rep_ = 0; rep_ < 2; ++rep_) { if (rep_) { asm volatile("s_waitcnt vmcnt(0)" ::: "memory"); __syncthreads(); }
#else
        {
#endif
        {
            const bf16_t* cb = CBUF + (size_t)(bh * 64 + c) * 36864;
#pragma unroll
            for (int i = 0; i < 9; ++i) { const int P = tid + 512 * i, row = P / 24, slot = P % 24, chk = slot ^ ((row >> 1) & 7);
                __builtin_amdgcn_global_load_lds((const unsigned*)(cb + (size_t)row * 192 + chk * 8), (LAS unsigned*)((LAS unsigned char*)CT + (wave * 64 + 512 * i) * 16), 16, 0, 0); }
        }
        if (tid < 384) {
            const int g = tid % 24, r = tid / 24, ch = h * 192 + g * 8;
#pragma unroll 1
            for (int qk = 0; qk < 2; ++qk) {
                const int col = qk * 768 + ch; const float scl = qk ? RS192 : 1.0f; LAS bf16_t* dst = qk ? Ks : Qs;
                u32x4 rw[7];
#pragma unroll
                for (int i = 0; i < 7; ++i) {
                    const int sp = 4 * r - 3 + i;
                    if (c * 64 + sp >= 0) rw[i] = *(const u32x4*)(U + (size_t)((long)tok0 + sp) * LDU1 + col); else rw[i] = (u32x4){0u, 0u, 0u, 0u};
                }
                f32x4 wv[4][2];
#pragma unroll
                for (int j = 0; j < 4; ++j) { wv[j][0] = *(const f32x4*)(qkw + j * 1536 + col); wv[j][1] = *(const f32x4*)(qkw + j * 1536 + col + 4); }
#pragma unroll
                for (int si = 0; si < 4; ++si) {
                    float v[8];
#pragma unroll
                    for (int e = 0; e < 8; ++e) v[e] = 0.f;
#pragma unroll
                    for (int j = 0; j < 4; ++j) {
                        const u32x4 a = rw[si + j];
                        v[0] += wv[j][0][0] * LO16(a.x); v[1] += wv[j][0][1] * HI16(a.x); v[2] += wv[j][0][2] * LO16(a.y); v[3] += wv[j][0][3] * HI16(a.y);
                        v[4] += wv[j][1][0] * LO16(a.z); v[5] += wv[j][1][1] * HI16(a.z); v[6] += wv[j][1][2] * LO16(a.w); v[7] += wv[j][1][3] * HI16(a.w);
                    }
#pragma unroll
                    for (int e = 0; e < 8; ++e) v[e] = silu_f(v[e]) * scl;
                    u32x4 w; w.x = pk2(v[0], v[1]); w.y = pk2(v[2], v[3]); w.z = pk2(v[4], v[5]); w.w = pk2(v[6], v[7]);
                    *(LAS u32x4*)(dst + (4 * r + si) * 200 + g * 8) = w;
                }
                asm volatile("" ::: "memory");
            }
        }
        {
            const int s = tid & 63, g0 = tid >> 6;
#pragma unroll
            for (int it = 0; it < 3; ++it) {
                const int g = g0 + 8 * it, ch = h * 192 + g * 8;
                const u32x4 vv = *(const u32x4*)(U + (tok0 + s) * LDU1 + 1536 + ch);
                LAS bf16_t* vd = VT + (g * 8) * 72 + s;
                vd[0] = (bf16_t)(vv.x & 0xffffu); vd[72] = (bf16_t)(vv.x >> 16); vd[2 * 72] = (bf16_t)(vv.y & 0xffffu); vd[3 * 72] = (bf16_t)(vv.y >> 16);
                vd[4 * 72] = (bf16_t)(vv.z & 0xffffu); vd[5 * 72] = (bf16_t)(vv.z >> 16); vd[6 * 72] = (bf16_t)(vv.w & 0xffffu); vd[7 * 72] = (bf16_t)(vv.w >> 16);
            }
        }
        {
            if (tid < 192) nS[tid] = NBUF[(size_t)(bh * 64 + c) * 192 + tid];
            if (tid < 64) { bcS[tid] = GB[(size_t)bh * SEQ + c * 64 + tid]; liS[tid] = GLI[(size_t)bh * SEQ + c * 64 + tid]; }
        }
        }
        const float mst = GM[bh * 64 + c];
        asm volatile("s_waitcnt vmcnt(0)" ::: "memory");
        __syncthreads();
        if (wave == 0) {
            const float bc = bcS[lane]; float pm = liS[lane] - bc;
#pragma unroll
            for (int o = 1; o < 64; o <<= 1) { const float t = __shfl_up(pm, o); if (lane >= o) pm = fmaxf(pm, t); }
            const float mt = bc + fmaxf(mst, pm);
            mtS[lane] = mt; winS[lane] = __expf(bc + mst - mt);
        }
        {
            const int t = tid >> 3, part = tid & 7; float sm = 0.f;
#pragma unroll 8
            for (int d = 0; d < 24; ++d) sm += bf2f(Qs[t * 200 + part * 24 + d]) * nS[part * 24 + d];
            sm += __shfl_xor(sm, 1); sm += __shfl_xor(sm, 2); sm += __shfl_xor(sm, 4);
            if (part == 0) qnS[t] = sm;
        }
        f32x4 sacc[2];
#pragma unroll
        for (int i = 0; i < 2; ++i) {
            const int tile = wave * 2 + i, tt = tile >> 2, st = tile & 3;
            const LAS bf16_t* ap = Qs + (tt * 16 + fr) * 200 + fq * 8; const LAS bf16_t* bp = Ks + (st * 16 + fr) * 200 + fq * 8;
            f32x4 a = {0.f, 0.f, 0.f, 0.f};
#pragma unroll
            for (int ks = 0; ks < 6; ++ks) a = MFMA16(*(const LAS bf16x8*)(ap + ks * 32), *(const LAS bf16x8*)(bp + ks * 32), a);
            sacc[i] = a;
        }
        __syncthreads();
#pragma unroll
        for (int i = 0; i < 2; ++i) {
            const int tile = wave * 2 + i, tt = tile >> 2, st = tile & 3, s = st * 16 + fr;
            const float gs = liS[s] - bcS[s];
#pragma unroll
            for (int j = 0; j < 4; ++j) {
                const int t = tt * 16 + fq * 4 + j;
                const float w = (s <= t) ? __expf(bcS[t] + gs - mtS[t]) : 0.f;
                const float scv = sacc[i][j] * w;
                Ps[t * 72 + s] = (bf16_t)f2bf(scv);
                float rs = scv; rs += __shfl_xor(rs, 1); rs += __shfl_xor(rs, 2); rs += __shfl_xor(rs, 4); rs += __shfl_xor(rs, 8);
                if (fr == 0) denP[t * 4 + st] = rs;
            }
        }
        __syncthreads();
        f32x4 hv[6];
        {
            const int tt = wave >> 1, dvt0 = (wave & 1) * 6;
            const LAS bf16_t* pp = Ps + (tt * 16 + fr) * 72 + fq * 8; const LAS bf16_t* qp = Qs + (tt * 16 + fr) * 200 + fq * 8;
            const bf16x8 pa0 = *(const LAS bf16x8*)pp, pa1 = *(const LAS bf16x8*)(pp + 32);
            bf16x8 qa[6];
#pragma unroll
            for (int ks = 0; ks < 6; ++ks) qa[ks] = *(const LAS bf16x8*)(qp + ks * 32);
            float win[4], rden[4];
#pragma unroll
            for (int j = 0; j < 4; ++j) { const int t = tt * 16 + fq * 4 + j; win[j] = winS[t];
                const float den = (denP[t * 4] + denP[t * 4 + 1]) + (denP[t * 4 + 2] + denP[t * 4 + 3]) + win[j] * qnS[t];
                rden[j] = 1.0f / fmaxf(fabsf(den), __expf(-mtS[t])); }
#pragma unroll
            for (int i = 0; i < 6; ++i) {
                const int dvt = dvt0 + i;
                const LAS bf16_t* vp = VT + (dvt * 16 + fr) * 72 + fq * 8; const LAS bf16_t* cp = CT + (dvt * 16 + fr) * 192; const int csw = (fr >> 1) & 7;
                f32x4 ia = {0.f, 0.f, 0.f, 0.f}, ie = {0.f, 0.f, 0.f, 0.f};
                ia = MFMA16(pa0, *(const LAS bf16x8*)vp, ia); ia = MFMA16(pa1, *(const LAS bf16x8*)(vp + 32), ia);
#pragma unroll
                for (int ks = 0; ks < 6; ++ks) ie = MFMA16(qa[ks], *(const LAS bf16x8*)(cp + ((ks * 4 + fq) ^ csw) * 8), ie);
#pragma unroll
                for (int j = 0; j < 4; ++j) hv[i][j] = (ia[j] + win[j] * ie[j]) * rden[j];
            }
        }
        __syncthreads();
        {
            const int tt = wave >> 1, dvt0 = (wave & 1) * 6;
#pragma unroll
            for (int i = 0; i < 6; ++i)
#pragma unroll
                for (int j = 0; j < 4; ++j) Hs[(tt * 16 + fq * 4 + j) * 196 + (dvt0 + i) * 16 + fr] = hv[i][j];
        }
        __syncthreads();
#ifdef M3_DUP_HN
#pragma unroll 1
        for (int rep_ = 0; rep_ < 2; ++rep_)
#endif
        {
            const float g0 = hng[h * 192 + lane], g1 = hng[h * 192 + lane + 64], g2 = hng[h * 192 + lane + 128];
#pragma unroll 1
            for (int rb = 0; rb < 2; ++rb) {
                float x[4][3], og[4][3];
#pragma unroll
                for (int r = 0; r < 4; ++r) { const int t = wave * 8 + rb * 4 + r;
                    const bf16_t* op = U + (tok0 + t) * LDU1 + 2304 + h * 192 + lane;
                    og[r][0] = bf2f(op[0]); og[r][1] = bf2f(op[64]); og[r][2] = bf2f(op[128]);
                    x[r][0] = Hs[t * 196 + lane]; x[r][1] = Hs[t * 196 + lane + 64]; x[r][2] = Hs[t * 196 + lane + 128]; }
                float mean[4], var[4];
#pragma unroll
                for (int r = 0; r < 4; ++r) mean[r] = x[r][0] + x[r][1] + x[r][2];
#pragma unroll
                for (int o = 1; o < 64; o <<= 1)
#pragma unroll
                    for (int r = 0; r < 4; ++r) mean[r] += __shfl_xor(mean[r], o);
#pragma unroll
                for (int r = 0; r < 4; ++r) { mean[r] *= (1.f / 192.f); x[r][0] -= mean[r]; x[r][1] -= mean[r]; x[r][2] -= mean[r]; var[r] = x[r][0] * x[r][0] + x[r][1] * x[r][1] + x[r][2] * x[r][2]; }
#pragma unroll
                for (int o = 1; o < 64; o <<= 1)
#pragma unroll
                    for (int r = 0; r < 4; ++r) var[r] += __shfl_xor(var[r], o);
#pragma unroll
                for (int r = 0; r < 4; ++r) { const int t = wave * 8 + rb * 4 + r;
                    const float rstd = 1.0f / sqrtf(var[r] * (1.f / 192.f) + LN_EPS);
                    bf16_t* mp = MIX + (tok0 + t) * DM + h * 192 + lane;
                    mp[0] = (bf16_t)f2bf(sigmoid_f(og[r][0]) * (x[r][0] * rstd * g0));
                    mp[64] = (bf16_t)f2bf(sigmoid_f(og[r][1]) * (x[r][1] * rstd * g1));
                    mp[128] = (bf16_t)f2bf(sigmoid_f(og[r][2]) * (x[r][2] * rstd * g2)); }
            }
        }
    }
}

#define XB_TMO      128
#define XB_XCNT(j)  (256  + 64 * (j))
#define XB_XSUB(j)  (1280 + 64 * (j))
#define XB_XGEN(j)  (2304 + 64 * (j))
#define XB_TOP      3328
#define XB_TOPGEN   3392
#define XCD_BAR_WORDS 3456
#define XB_SPIN_CAP (1u << 18)
__device__ __forceinline__ unsigned xb_ld(unsigned* p)              { return __hip_atomic_load(p, __ATOMIC_RELAXED, __HIP_MEMORY_SCOPE_AGENT); }
__device__ __forceinline__ unsigned xb_add(unsigned* p, unsigned v) { return __hip_atomic_fetch_add(p, v, __ATOMIC_RELAXED, __HIP_MEMORY_SCOPE_AGENT); }
__device__ __forceinline__ unsigned xb_xcc_id() { return (unsigned)__builtin_amdgcn_s_getreg((3 << 11) | 20) & 0xFu; }
#define XB_SPIN(cond, bar) do { unsigned _sp = 0; while (cond) { __builtin_amdgcn_s_sleep(1); \
    if ((++_sp & 255u) == 0u) { if (xb_ld(&(bar)[XB_TMO])) break; if (_sp > XB_SPIN_CAP) { atomicAdd(&(bar)[XB_TMO], 1u); break; } } } } while (0)
__device__ __forceinline__ void xcd_barrier_complete(unsigned* bar, unsigned x, unsigned& nloc, unsigned& nx) {
    const unsigned G = gridDim.x * gridDim.y * gridDim.z;
    unsigned sum, cnt, mine, sp = 0u;
    for (;;) {
        sum = 0u; cnt = 0u; mine = 0u;
#pragma unroll
        for (unsigned j = 0; j < 16; ++j) { const unsigned c = xb_ld(&bar[XB_XCNT(j)]); sum += c; cnt += (c > 0u) ? 1u : 0u; mine = (j == x) ? c : mine; }
        if (sum == G) break;
        __builtin_amdgcn_s_sleep(1);
        if ((++sp & 255u) == 0u) { if (xb_ld(&bar[XB_TMO])) break; if (sp > XB_SPIN_CAP) { atomicAdd(&bar[XB_TMO], 1u); break; } }
    }
    nloc = mine > 0u ? mine : 1u; nx = cnt > 0u ? cnt : 1u;
}
__device__ __forceinline__ void xcd_barrier(unsigned* bar, volatile LAS unsigned* st) {
    asm volatile("s_waitcnt vmcnt(0)" ::: "memory");
    __syncthreads();
    if (threadIdx.x == 0) {
        __builtin_amdgcn_s_waitcnt(0);
        const unsigned x = xb_xcc_id();
        unsigned nloc = st[0], nx = st[1];
        if (nloc == 0u) { xcd_barrier_complete(bar, x, nloc, nx); st[0] = nloc; st[1] = nx; }
        const unsigned old = xb_add(&bar[XB_XSUB(x)], 1u);
        const unsigned gen = old / nloc;
        if (old + 1u == (gen + 1u) * nloc) {
            __builtin_amdgcn_fence(__ATOMIC_RELEASE, "agent");
            asm volatile("s_waitcnt vmcnt(0)" ::: "memory");
            const unsigned og = xb_add(&bar[XB_TOP], 1u);
            const unsigned tg = og / nx;
            if (og + 1u == (tg + 1u) * nx) xb_add(&bar[XB_TOPGEN], 1u);
            else XB_SPIN(xb_ld(&bar[XB_TOPGEN]) == tg, bar);
            __builtin_amdgcn_fence(__ATOMIC_ACQUIRE, "agent");
            xb_add(&bar[XB_XGEN(x)], 1u);
            asm volatile("s_waitcnt vmcnt(0)" ::: "memory");
        } else {
            XB_SPIN(xb_ld(&bar[XB_XGEN(x)]) == gen, bar);
            __builtin_amdgcn_fence(__ATOMIC_ACQUIRE, "agent");
            asm volatile("s_waitcnt vmcnt(0)" ::: "memory");
        }
    }
    __syncthreads();
}

__device__ __forceinline__ int opaque_tid() { int t = threadIdx.x; asm volatile("" : "+v"(t)); return t; }
__global__ void __launch_bounds__(512, 2) fwd_kernel(Params p) {
    extern __shared__ __attribute__((aligned(16))) unsigned char shm[];
    LAS unsigned char* lds = (LAS unsigned char*)shm;
    cg::grid_group grid = cg::this_grid();
#define tid (opaque_tid())
#define wave (__builtin_amdgcn_readfirstlane(opaque_tid() >> 6))
#define lane (opaque_tid() & 63)
#define gw ((int)blockIdx.x * 8 + wave)
#define ngw ((int)gridDim.x * 8)
#define gtid ((size_t)blockIdx.x * 512 + opaque_tid())
#define nthr ((size_t)gridDim.x * 512)
    unsigned char* ws = p.ws;
    bf16_t* XB = (bf16_t*)(ws + OFF_XB); bf16_t* HU = (bf16_t*)(ws + OFF_HU); bf16_t* CBUF = (bf16_t*)(ws + OFF_CBUF);
    bf16_t* MEMB = (bf16_t*)(ws + OFF_MEMB); float* GATES = (float*)(ws + OFF_GATES); float* NBUF = (float*)(ws + OFF_NBUF);
    float* GB = (float*)(ws + OFF_GB); float* GLI = (float*)(ws + OFF_GLI); float* GM = (float*)(ws + OFF_GM);
    float* X = p.out;
    unsigned* bar = (unsigned*)(ws + OFF_BAR);
    volatile LAS unsigned* bst = (volatile LAS unsigned*)(lds + LDS_MAIN);
    if (threadIdx.x == 0) { bst[0] = 0u; bst[1] = 0u; (void)xb_add(&bar[XB_XCNT(xb_xcc_id())], 1u); }
    __syncthreads();
    if (gridDim.x == 0x7fffffffu) grid.sync();
#define GRID_SYNC() xcd_barrier(bar, bst)

#ifndef NO_PRO
#pragma unroll 1
    for (int i = 0; i < EXTRA_SYNC; ++i) GRID_SYNC();
    if (DUP_PRO) { prologue(p, lds, gw, ngw, wave, lane, gtid, nthr); GRID_SYNC(); }
    prologue(p, lds, gw, ngw, wave, lane, gtid, nthr);
#endif
    GRID_SYNC();

#pragma unroll 1
    for (int l = 0; l < 2; ++l) {
#pragma unroll 1
#ifdef DUP_M12
        for (int sti = 0; sti < 14 + (l == 1 ? 2 : 0); ++sti) {
            const int st = (l == 1 && sti > 7) ? sti - 2 : sti;
#else
        for (int sti = 0; sti < 14 + ((DUP_ST >= 0 && (DUP_L < 0 || DUP_L == l)) ? 1 : 0); ++sti) {
            const int st = (DUP_ST >= 0 && (DUP_L < 0 || DUP_L == l) && sti > DUP_ST) ? sti - 1 : sti;
#endif
            if (l == 0 && st >= 6 && st <= 8) continue;
            bf16_t* MEMKV = (bf16_t*)(ws + OFF_MEMKV) + l * 512;
            if (l == 1 && st == 3) continue;
            const int gk = (st == 0 || st == 11) ? 0 : (st == 1 || st == 12) ? 1 : st == 3 ? 2 : st == 4 ? 3 : st == 9 ? 4 : -1;
            if (gk >= 0) {
#ifndef NO_G1
                const int m = l * 2 + (st >= 11 ? 1 : 0);
                pg8::Gemm g; EpiAll E;
                E.O = HU; E.ldc = FF; E.nstore = 0; E.gates = GATES; E.gate_pn = -1; E.res = X; E.resb = nullptr; E.out = X; E.scale = 1.0f;
                if (gk == 0) { g.A = XB; g.Bt = (const bf16_t*)(ws + OFF_WGU + m * SZ_WGU); g.M = NTOK; g.N = 2 * FF; g.K = DM; E.mode = 0; }
                else if (gk == 1) { g.A = HU; g.Bt = (const bf16_t*)(ws + OFF_WD + m * SZ_WD); g.M = NTOK; g.N = DM; g.K = FF; E.mode = 1; E.res = p.x; E.resb = (l == 0 && st == 1) ? (const bf16_t*)nullptr : XB; E.scale = 0.5f; }
                else if (gk == 2) { g.A = MEMB; g.Bt = (const bf16_t*)(ws + OFF_WKV + l * SZ_WKV); g.M = 2048; g.N = 1024; g.K = DM; E.mode = 2; E.O = MEMKV; E.ldc = 1024; E.nstore = 4; }
                else if (gk == 3) { g.A = XB; g.Bt = (const bf16_t*)(ws + (l == 0 ? OFF_WIN0 : OFF_WIN1)); g.M = NTOK; g.N = (l == 0 ? LDU0 : NIN1P); g.K = DM; E.mode = 2; E.ldc = (l == 0 ? LDU0 : LDU1); E.nstore = (l == 0 ? 10 : 13); E.gate_pn = (l == 0 ? -1 : 13); }
                else { g.A = XB; g.Bt = (const bf16_t*)(ws + OFF_WOUT + l * SZ_WOUT); g.M = NTOK; g.N = DM; g.K = DM; E.mode = 1; }
                pg8::StaticOrder S; S.init(g.M, g.N, (int)gridDim.x, (int)blockIdx.x);
                pg8::gemm_phase<EpiAll, pg8::StaticOrder, PG8_ALIGN, PG8_SP2>(lds, g, S, E);
#endif
            } else if (st == 2 || st == 10 || st == 13) {
                const int kind = st == 2 ? 0 : (st == 10 ? 1 : 2);
#ifndef NO_LN
                ln_phase(X, X, XB, p.ln_g + (size_t)(l * 3 + kind) * DM, p.ln_b + (size_t)(l * 3 + kind) * DM, kind == 0 || (l == 1 && kind == 2), !(l == 1 && kind == 2), gw, ngw, lane);
#endif
            } else if (st == 5) {
                if (l == 0) {
#ifndef NO_MIX0
                    conv_phase(HU, p.convw, XB, gtid, nthr);
                    xattn_phase(lds, HU, LDU0, 2304, MEMKV, XB, tid);
#endif
                } else {
#ifndef NO_M0
                    m0_phase(GATES, p.bgates, GB, GLI, GM, gw, ngw, lane);
                    xattn_phase(lds, HU, LDU1, 3072, MEMKV, XB, tid);
#endif
                }
            } else if (st == 6) {
#ifndef NO_M1
                m1_phase(lds, HU, p.qkconvw, GB, GLI, GM, GM, CBUF, NBUF, tid);
#endif
            } else if (st == 7) {
#ifndef NO_M2
                m2_phase(CBUF, NBUF, GM, tid);
#endif
            } else {
#ifndef NO_M3
                m3_phase(lds, HU, p.qkconvw, p.hng, GB, GLI, GM, CBUF, NBUF, XB, tid);
#endif
            }
            if (st != 3 && !(l == 1 && st == 13)) GRID_SYNC();
        }
    }
}

#undef GRID_SYNC
#undef tid
#undef wave
#undef lane
#undef gw
#undef ngw
#undef gtid
#undef nthr
extern "C" void kernel_launch(void* const* d_in, const int* in_sizes, int n_in, void* d_out, int out_size, void* d_ws, size_t ws_size, hipStream_t stream) {
    static int grid_blocks = 0;
    if (grid_blocks == 0) {
        if (n_in != 15 || ws_size < WS_END) { fprintf(stderr, "kernel_launch: unexpected n_in %d or workspace %zu < %zu\n", n_in, ws_size, (size_t)WS_END); grid_blocks = -1; return; }
        int dev = 0, cus = 0, per_cu = 0;
        hipGetDevice(&dev);
        hipDeviceGetAttribute(&cus, hipDeviceAttributeMultiprocessorCount, dev);
        if (hipFuncSetAttribute((const void*)fwd_kernel, hipFuncAttributeMaxDynamicSharedMemorySize, LDS_BYTES) != hipSuccess) fprintf(stderr, "kernel_launch: hipFuncSetAttribute failed\n");
        if (hipOccupancyMaxActiveBlocksPerMultiprocessor(&per_cu, (const void*)fwd_kernel, 512, LDS_BYTES) != hipSuccess || per_cu < 1) { per_cu = 1; (void)hipGetLastError(); }
        grid_blocks = cus * 1;
        (void)per_cu;
    }
    if (grid_blocks < 0) return;
    Params p{};
    p.x = (const float*)d_in[0]; p.mem = (const float*)d_in[1]; p.ln_g = (const float*)d_in[2]; p.ln_b = (const float*)d_in[3];
    p.wg = (const float*)d_in[4]; p.wu = (const float*)d_in[5]; p.wd = (const float*)d_in[6]; p.wkv = (const float*)d_in[7]; p.wout = (const float*)d_in[8];
    p.win0 = (const float*)d_in[9]; p.convw = (const float*)d_in[10]; p.win1 = (const float*)d_in[11]; p.bgates = (const float*)d_in[12];
    p.qkconvw = (const float*)d_in[13]; p.hng = (const float*)d_in[14];
    p.out = (float*)d_out; p.ws = (unsigned char*)d_ws;
    if (hipMemsetAsync((unsigned char*)d_ws + OFF_BAR, 0, (size_t)3456 * 4, stream) != hipSuccess) fprintf(stderr, "kernel_launch: hipMemsetAsync failed\n");
    void* args[] = {&p};
    hipError_t e = hipLaunchCooperativeKernel((const void*)fwd_kernel, dim3(grid_blocks), dim3(512), args, LDS_BYTES, stream);
    if (e != hipSuccess) fprintf(stderr, "kernel_launch: cooperative launch failed: %s (grid %d)\n", hipGetErrorString(e), grid_blocks);
}
```

```cpp
#include <hip/hip_runtime.h>
#include <hip/hip_cooperative_groups.h>
#include <cstdio>
#include <cstdint>
namespace cg = cooperative_groups;
namespace pg8 {
#define PG8_LAS __attribute__((address_space(3)))
typedef unsigned short bf16_t;
typedef short bf16x8 __attribute__((ext_vector_type(8)));
typedef float f32x4 __attribute__((ext_vector_type(4)));
typedef unsigned u32x4 __attribute__((ext_vector_type(4)));
constexpr int BM = 256, BK = 64, HALF = 128, HTB = HALF * BK * 2  , STAGE_BYTES = 8 * HTB, NXCD = 8, WGM = 8;

__host__ __device__ __forceinline__ int lds_byte(int r, int c) { const int st = (r >> 4) * 2 + (c >> 5), rr = r & 15, cc = c & 31, ob = rr * 64 + cc * 2; return st * 1024 + (ob ^ (((ob >> 9) & 1) << 5)); }
__host__ __device__ __forceinline__ void stage_rc(int b, int& R, int& C) { const int st = b / 1024, sb = b % 1024, swz = sb ^ (((sb >> 9) & 1) << 5); R = (st >> 1) * 16 + swz / 64; C = (st & 1) * 32 + (swz % 64) / 2; }
__host__ __device__ __forceinline__ int perm32(int rho) { const int n = rho >> 4, i = rho & 15; return 8 * (i >> 2) + 4 * n + (i & 3); }

struct Unit { int pm, pn; };
struct Gemm { const bf16_t* A; const bf16_t* Bt; int M, N, K; };

struct StaticOrder {
    int nM, nN, nwg, G, c;
    __host__ __device__ void init(int M, int N, int G_, int c_) { nM = M / BM; nN = N / BM; nwg = nM * nN; G = G_; c = c_; }
    __host__ __device__ bool next(int i, Unit& u) const {
        const long L = (long)i * G + c; if (L >= nwg) return false;
        int wgid = (int)L; { const int q = nwg / NXCD, r = nwg % NXCD, xcd = wgid % NXCD, off = wgid / NXCD; wgid = (xcd < r ? xcd * (q + 1) : r * (q + 1) + (xcd - r) * q) + off; }
        const int nig = WGM * nN, gid = wgid / nig, fm = gid * WGM, gsz = (nM - fm) < WGM ? (nM - fm) : WGM;
        u.pm = fm + ((wgid % nig) % gsz); u.pn = (wgid % nig) / gsz; return true;
    }
    __device__ __forceinline__ void a_ready(const Unit&) const {}
    __device__ __forceinline__ void done(const Unit&) const {}
};
__device__ __forceinline__ unsigned cvt_pk_bf16(float lo, float hi) { unsigned r; asm volatile("v_cvt_pk_bf16_f32 %0, %1, %2" : "=v"(r) : "v"(lo), "v"(hi)); return r; }
typedef float f32x2 __attribute__((ext_vector_type(2)));
template <class Epi, class Sched, bool ALIGN_EPI = false, bool SP2 = false>
__device__ __forceinline__ void gemm_phase(PG8_LAS unsigned char* lds, const Gemm g, const Sched& S, const Epi& E) {
    int tid_ = threadIdx.x; asm volatile("" : "+v"(tid_));
    const int tid = tid_, wid = __builtin_amdgcn_readfirstlane(tid >> 6), lane = tid & 63, wr = wid >> 2, wc = wid & 3, fr = lane & 15, fq = lane >> 4;
    const int K = g.K, nt = K / BK;
    unsigned voffA[2], voffB[2];
#pragma unroll
    for (int i = 0; i < 2; ++i) { int R, C; stage_rc(tid * 16 + i * 8192, R, C); const int Rb = Epi::PERM ? ((R & ~31) + perm32(R & 31)) : R;
        voffA[i] = (unsigned)(R * K + C) * 2u; voffB[i] = (unsigned)(Rb * K + C) * 2u; }
    const size_t kstep = (size_t)(BK * 2);
    const size_t hstep = (size_t)HALF * K * 2;
    const size_t tstep = 2 * hstep;
    const unsigned ldsw = (unsigned)wid * 1024u;
    const int aoff = lds_byte(wr * 64 + fr, fq * 8), boff = lds_byte(wc * 32 + fr, fq * 8);
#define PG8_SA(b, h) (((b) * 2 + (h)) * HTB)
#define PG8_SB(b, h) ((4 + (b) * 2 + (h)) * HTB)
#define PG8_STAGE(bufoff, gbase, voff) do { _Pragma("unroll") for (int _i = 0; _i < 2; ++_i) \
        __builtin_amdgcn_global_load_lds((const unsigned*)((const char*)(gbase) + (voff)[_i]), (PG8_LAS unsigned*)(lds + (bufoff) + ldsw + _i * 8192), 16, 0, 0); } while (0)
#define PG8_LDA(dst, b, h) do { _Pragma("unroll") for (int m = 0; m < 4; ++m) _Pragma("unroll") for (int k = 0; k < 2; ++k) dst[m][k] = *(const PG8_LAS bf16x8*)(lds + PG8_SA(b, h) + aoff + m * 2048 + k * 1024); } while (0)
#define PG8_LDB(dst, b, h) do { _Pragma("unroll") for (int n = 0; n < 2; ++n) _Pragma("unroll") for (int k = 0; k < 2; ++k) dst[n][k] = *(const PG8_LAS bf16x8*)(lds + PG8_SB(b, h) + boff + n * 2048 + k * 1024); } while (0)
#define PG8_MMA(ai, bj, At, Bt) do { __builtin_amdgcn_s_setprio(1); _Pragma("unroll") for (int m = 0; m < 4; ++m) _Pragma("unroll") for (int n = 0; n < 2; ++n) _Pragma("unroll") for (int k = 0; k < 2; ++k) \
        acc[ai][bj][m][n] = __builtin_amdgcn_mfma_f32_16x16x32_bf16(Bt[n][k], At[m][k], acc[ai][bj][m][n], 0, 0, 0); __builtin_amdgcn_s_setprio(0); } while (0)
#define PG8_WAIT_V(n) asm volatile("s_waitcnt vmcnt(" #n ")" ::: "memory")
#define PG8_WAIT_L(n) asm volatile("s_waitcnt lgkmcnt(" #n ")" ::: "memory")
#define PG8_BAR __builtin_amdgcn_s_barrier()
#define PG8_SCHED __builtin_amdgcn_sched_barrier(0)
    Unit cur, nxt; int ui = 0;
    if (!S.next(0, cur)) return;
    f32x4 acc[2][2][4][2];
#pragma unroll
    for (int a = 0; a < 2; ++a)
#pragma unroll
        for (int b = 0; b < 2; ++b)
#pragma unroll
            for (int m = 0; m < 4; ++m)
#pragma unroll
                for (int n = 0; n < 2; ++n) acc[a][b][m][n] = (f32x4){0.f, 0.f, 0.f, 0.f};
    bf16x8 At[4][2], B0[2][2], B1[2][2];
    const char* cA = (const char*)g.A + (size_t)cur.pm * tstep; const char* cB = (const char*)g.Bt + (size_t)cur.pn * tstep;
    S.a_ready(cur);
    if constexpr (SP2) {
        PG8_STAGE(PG8_SB(0, 0), cB, voffB); PG8_STAGE(PG8_SB(0, 1), cB + hstep, voffB); PG8_STAGE(PG8_SA(0, 0), cA, voffA); PG8_STAGE(PG8_SA(0, 1), cA + hstep, voffA);
        if (wr == 1) PG8_BAR;
        PG8_WAIT_V(2); PG8_BAR;
        PG8_STAGE(PG8_SB(1, 0), cB + kstep, voffB); PG8_STAGE(PG8_SA(1, 0), cA + kstep, voffA); PG8_STAGE(PG8_SB(1, 1), cB + hstep + kstep, voffB);
        PG8_WAIT_V(6); PG8_BAR;
    } else {
        PG8_STAGE(PG8_SB(0, 0), cB, voffB); PG8_STAGE(PG8_SA(0, 0), cA, voffA); PG8_STAGE(PG8_SB(0, 1), cB + hstep, voffB); PG8_STAGE(PG8_SA(0, 1), cA + hstep, voffA);
        if (wr == 1) PG8_BAR;
        PG8_WAIT_V(4); PG8_BAR;
        PG8_STAGE(PG8_SB(1, 0), cB + kstep, voffB); PG8_STAGE(PG8_SA(1, 0), cA + kstep, voffA); PG8_STAGE(PG8_SB(1, 1), cB + hstep + kstep, voffB);
        PG8_WAIT_V(6); PG8_BAR;
    }
    for (;;) {
        const bool has_next = S.next(ui + 1, nxt);
        const char* nA = has_next ? (const char*)g.A + (size_t)nxt.pm * tstep : cA; const char* nB = has_next ? (const char*)g.Bt + (size_t)nxt.pn * tstep : cB;
        for (int t = 0; t < nt; t += 2) {
            const bool last = (t == nt - 2);
            const char* a1 = cA + (size_t)(t + 1) * kstep;
            const char* a2 = last ? nA : cA + (size_t)(t + 2) * kstep; const char* b2 = last ? nB : cB + (size_t)(t + 2) * kstep;
            const char* a3 = a2 + kstep; const char* b3 = b2 + kstep;
            if (last && has_next) S.a_ready(nxt);
            if constexpr (SP2) {
            PG8_LDB(B0, 0, 0); PG8_LDB(B1, 0, 1); PG8_SCHED; PG8_LDA(At, 0, 0); PG8_STAGE(PG8_SA(1, 1), a1 + hstep, voffA);
            PG8_WAIT_V(8); PG8_WAIT_L(0); PG8_BAR; PG8_MMA(0, 0, At, B0); PG8_MMA(0, 1, At, B1); PG8_BAR; PG8_SCHED;
            PG8_LDA(At, 0, 1); PG8_STAGE(PG8_SB(0, 0), b2, voffB); PG8_STAGE(PG8_SB(0, 1), b2 + hstep, voffB); PG8_STAGE(PG8_SA(0, 0), a2, voffA);
            PG8_WAIT_V(8); PG8_WAIT_L(0); PG8_BAR; PG8_MMA(1, 0, At, B0); PG8_MMA(1, 1, At, B1); PG8_BAR; PG8_SCHED;
            PG8_LDB(B0, 1, 0); PG8_LDB(B1, 1, 1); PG8_SCHED; PG8_LDA(At, 1, 0); PG8_STAGE(PG8_SA(0, 1), a2 + hstep, voffA);
            PG8_WAIT_V(8); PG8_WAIT_L(0); PG8_BAR; PG8_MMA(0, 0, At, B0); PG8_MMA(0, 1, At, B1); PG8_BAR; PG8_SCHED;
            PG8_LDA(At, 1, 1); PG8_STAGE(PG8_SB(1, 0), b3, voffB); PG8_STAGE(PG8_SB(1, 1), b3 + hstep, voffB); PG8_STAGE(PG8_SA(1, 0), a3, voffA);
            PG8_WAIT_V(8); PG8_WAIT_L(0); PG8_BAR; PG8_MMA(1, 0, At, B0); PG8_MMA(1, 1, At, B1); PG8_BAR; PG8_SCHED;
            } else {
            PG8_LDB(B0, 0, 0); PG8_SCHED; PG8_LDA(At, 0, 0); PG8_STAGE(PG8_SA(1, 1), a1 + hstep, voffA);
            PG8_WAIT_L(8); PG8_BAR; PG8_WAIT_L(0); PG8_MMA(0, 0, At, B0); PG8_BAR; PG8_SCHED;
            PG8_LDB(B1, 0, 1); PG8_STAGE(PG8_SB(0, 0), b2, voffB);
            PG8_BAR; PG8_WAIT_L(0); PG8_MMA(0, 1, At, B1); PG8_BAR;
            PG8_LDA(At, 0, 1); PG8_STAGE(PG8_SA(0, 0), a2, voffA);
            PG8_BAR; PG8_WAIT_L(0); PG8_MMA(1, 0, At, B0); PG8_BAR; PG8_SCHED;
            PG8_STAGE(PG8_SB(0, 1), b2 + hstep, voffB);
            PG8_WAIT_V(6); PG8_BAR; PG8_MMA(1, 1, At, B1); PG8_BAR;
            PG8_LDB(B0, 1, 0); PG8_SCHED; PG8_LDA(At, 1, 0); PG8_STAGE(PG8_SA(0, 1), a2 + hstep, voffA);
            PG8_WAIT_L(8); PG8_BAR; PG8_WAIT_L(0); PG8_MMA(0, 0, At, B0); PG8_BAR; PG8_SCHED;
            PG8_LDB(B1, 1, 1); PG8_STAGE(PG8_SB(1, 0), b3, voffB);
            PG8_BAR; PG8_WAIT_L(0); PG8_MMA(0, 1, At, B1); PG8_BAR;
            PG8_LDA(At, 1, 1); PG8_STAGE(PG8_SA(1, 0), a3, voffA);
            PG8_BAR; PG8_WAIT_L(0); PG8_MMA(1, 0, At, B0); PG8_BAR; PG8_SCHED;
            PG8_STAGE(PG8_SB(1, 1), b3 + hstep, voffB);
            PG8_WAIT_V(6); PG8_BAR; PG8_MMA(1, 1, At, B1); PG8_BAR;
            }
        }
        if constexpr (ALIGN_EPI) { if (wr == 0) PG8_BAR; }
        if constexpr (!Epi::AFTER_DRAIN) { E(acc, cur, wr, wc, fr, fq); S.done(cur); }
        if (!has_next) break;
#pragma unroll
        for (int a = 0; a < 2; ++a)
#pragma unroll
            for (int b = 0; b < 2; ++b)
#pragma unroll
                for (int m = 0; m < 4; ++m)
#pragma unroll
                    for (int n = 0; n < 2; ++n) acc[a][b][m][n] = (f32x4){0.f, 0.f, 0.f, 0.f};
        cur = nxt; cA = nA; cB = nB; ++ui;
        if constexpr (ALIGN_EPI) { if (wr == 1) PG8_BAR; }
    }
    PG8_WAIT_V(0);
    if constexpr (!ALIGN_EPI) { if (wr == 0) PG8_BAR; }
    PG8_BAR;
    if constexpr (Epi::AFTER_DRAIN) { E.fused(acc, cur, wr, wc, fr, fq, lds, wid, lane); S.done(cur); }
#undef PG8_SA
#undef PG8_SB
#undef PG8_STAGE
#undef PG8_LDA
#undef PG8_LDB
#undef PG8_MMA
#undef PG8_WAIT_V
#undef PG8_WAIT_L
#undef PG8_BAR
#undef PG8_SCHED
}
}

using pg8::bf16_t; using pg8::bf16x8; using pg8::f32x4; using pg8::u32x4; using pg8::Unit;
#define LAS __attribute__((address_space(3)))
typedef unsigned u32x2 __attribute__((ext_vector_type(2)));

constexpr int NTOK = 32768, DM = 1024, FF = 2816, SEQ = 4096;
constexpr int LDU0 = 2560, LDU1 = 3328, NIN1P = 3584, NS1 = 3336;
constexpr float LN_EPS = 1e-5f, ALPHA = 1.41421356237f, RS192 = 0.07216878364870322f;
constexpr int LDS_MAIN = 158720, LDS_BYTES = LDS_MAIN + 16;
#ifndef PG8_SP2
#define PG8_SP2 true
#endif
#ifndef PG8_ALIGN
#define PG8_ALIGN true
#endif
#ifndef DUP_ST
#define DUP_ST (-1)
#endif
#ifndef DUP_L
#define DUP_L (-1)
#endif
#ifndef EXTRA_SYNC
#define EXTRA_SYNC 0
#endif
#ifndef DUP_PRO
#define DUP_PRO 0
#endif
#ifndef DUP_LN
#define DUP_LN 0
#endif

constexpr size_t SZ_WGU = (size_t)5632 * 1024 * 2, SZ_WD = (size_t)1024 * 2816 * 2, SZ_WKV = (size_t)512 * 1024 * 2, SZ_WOUT = (size_t)1024 * 1024 * 2;
constexpr size_t OFF_WGU = 0;
constexpr size_t OFF_WD = OFF_WGU + 4 * SZ_WGU;
constexpr size_t OFF_WKV = OFF_WD + 4 * SZ_WD;
constexpr size_t OFF_WOUT = OFF_WKV + 2 * SZ_WKV;
constexpr size_t OFF_WIN0 = OFF_WOUT + 2 * SZ_WOUT;
constexpr size_t OFF_WIN1 = OFF_WIN0 + (size_t)2560 * 1024 * 2;
constexpr size_t OFF_XB = OFF_WIN1 + (size_t)NIN1P * 1024 * 2;
constexpr size_t OFF_HU = OFF_XB + (size_t)NTOK * 1024 * 2;
constexpr size_t OFF_CBUF = OFF_HU + (size_t)NTOK * LDU1 * 2;
constexpr size_t OFF_MEMB = OFF_CBUF + (size_t)2048 * 36864 * 2;
constexpr size_t OFF_MEMKV = OFF_MEMB + (size_t)2048 * 1024 * 2;
constexpr size_t OFF_GATES = OFF_MEMKV + (size_t)2 * 2048 * 512 * 2;
constexpr size_t OFF_NBUF = OFF_GATES + (size_t)NTOK * 8 * 4;
constexpr size_t OFF_GB = OFF_NBUF + (size_t)2048 * 192 * 4;
constexpr size_t OFF_GLI = OFF_GB + (size_t)32 * 4096 * 4;
constexpr size_t OFF_GM = OFF_GLI + (size_t)32 * 4096 * 4;
constexpr size_t OFF_BAR = OFF_GM + (size_t)5 * 2048 * 4;
constexpr size_t WS_END = OFF_BAR + (size_t)3456 * 4;

struct Params {
    const float *x, *mem, *ln_g, *ln_b, *wg, *wu, *wd, *wkv, *wout, *win0, *convw, *win1, *bgates, *qkconvw, *hng;
    float* out; unsigned char* ws;
};

__device__ __forceinline__ float bf2f(unsigned b) { return __uint_as_float(b << 16); }
__device__ __forceinline__ unsigned f2bf(float f) { unsigned u = __float_as_uint(f); u += 0x7FFFu + ((u >> 16) & 1u); return u >> 16; }
__device__ __forceinline__ unsigned pk2(float lo, float hi) { return f2bf(lo) | (f2bf(hi) << 16); }
__device__ __forceinline__ float silu_f(float v) { return v * __builtin_amdgcn_rcpf(1.0f + __expf(-v)); }
__device__ __forceinline__ float sigmoid_f(float v) { return __builtin_amdgcn_rcpf(1.0f + __expf(-v)); }
__device__ __forceinline__ float wsum(float v) {
#pragma unroll
    for (int o = 1; o < 64; o <<= 1) v += __shfl_xor(v, o);
    return v;
}
__device__ __forceinline__ float wmax(float v) {
#pragma unroll
    for (int o = 1; o < 64; o <<= 1) v = fmaxf(v, __shfl_xor(v, o));
    return v;
}
#define LO16(w) bf2f((w) & 0xffffu)
#define HI16(w) __uint_as_float((w) & 0xffff0000u)
#define MFMA16(a, b, c) __builtin_amdgcn_mfma_f32_16x16x32_bf16((a), (b), (c), 0, 0, 0)

struct EpiSwiglu {
    static constexpr bool PERM = true, AFTER_DRAIN = false;
    bf16_t* H;
    __device__ __forceinline__ void operator()(const f32x4 (&acc)[2][2][4][2], const Unit& u, int wr, int wc, int fr, int fq) const {
        const int row0 = u.pm * 256 + wr * 64 + fr, col0 = u.pn * 128 + wc * 32 + 8 * fq;
#pragma unroll
        for (int ai = 0; ai < 2; ++ai)
#pragma unroll
            for (int m = 0; m < 4; ++m) {
                bf16_t* rowp = H + (size_t)(row0 + ai * 128 + m * 16) * FF + col0;
                const f32x4 g0 = acc[ai][0][m][0], g1 = acc[ai][0][m][1], u0 = acc[ai][1][m][0], u1 = acc[ai][1][m][1];
                u32x4 w;
                w.x = pg8::cvt_pk_bf16(silu_f(g0[0]) * u0[0], silu_f(g0[1]) * u0[1]);
                w.y = pg8::cvt_pk_bf16(silu_f(g0[2]) * u0[2], silu_f(g0[3]) * u0[3]);
                w.z = pg8::cvt_pk_bf16(silu_f(g1[0]) * u1[0], silu_f(g1[1]) * u1[1]);
                w.w = pg8::cvt_pk_bf16(silu_f(g1[2]) * u1[2], silu_f(g1[3]) * u1[3]);
                *(u32x4*)rowp = w;
            }
    }
};
struct EpiRes {
    static constexpr bool PERM = false, AFTER_DRAIN = false;
    const float* res; float* out; float scale;
    __device__ __forceinline__ void operator()(const f32x4 (&acc)[2][2][4][2], const Unit& u, int wr, int wc, int fr, int fq) const {
        const int row0 = u.pm * 256 + wr * 64 + fr, col0 = u.pn * 256 + wc * 32 + 4 * fq;
#pragma unroll
        for (int ai = 0; ai < 2; ++ai)
#pragma unroll
            for (int m = 0; m < 4; ++m) {
                const size_t off = (size_t)(row0 + ai * 128 + m * 16) * DM + col0;
#pragma unroll
                for (int bj = 0; bj < 2; ++bj)
#pragma unroll
                    for (int n = 0; n < 2; ++n) {
                        const f32x4 r = *(const f32x4*)(res + off + bj * 128 + n * 16);
                        *(f32x4*)(out + off + bj * 128 + n * 16) = r * ALPHA + acc[ai][bj][m][n] * scale;
                    }
                asm volatile("" ::: "memory");
            }
    }
};
struct EpiU {
    static constexpr bool PERM = true, AFTER_DRAIN = false;
    bf16_t* O; int ldc; int nstore; float* gates; int gate_pn;
    __device__ __forceinline__ void operator()(const f32x4 (&acc)[2][2][4][2], const Unit& u, int wr, int wc, int fr, int fq) const {
        const int row0 = u.pm * 256 + wr * 64 + fr;
        if (u.pn < nstore) {
            const int col0 = u.pn * 256 + wc * 32 + 8 * fq;
#pragma unroll
            for (int ai = 0; ai < 2; ++ai)
#pragma unroll
                for (int m = 0; m < 4; ++m) {
                    bf16_t* rowp = O + (size_t)(row0 + ai * 128 + m * 16) * ldc + col0;
#pragma unroll
                    for (int bj = 0; bj < 2; ++bj) {
                        const f32x4 v0 = acc[ai][bj][m][0], v1 = acc[ai][bj][m][1];
                        u32x4 w; w.x = pg8::cvt_pk_bf16(v0[0], v0[1]); w.y = pg8::cvt_pk_bf16(v0[2], v0[3]); w.z = pg8::cvt_pk_bf16(v1[0], v1[1]); w.w = pg8::cvt_pk_bf16(v1[2], v1[3]);
                        *(u32x4*)(rowp + bj * 128) = w;
                    }
                }
        } else if (u.pn == gate_pn) {
            if (wc == 0 && fq == 0) {
#pragma unroll
                for (int ai = 0; ai < 2; ++ai)
#pragma unroll
                    for (int m = 0; m < 4; ++m) {
                        float* gp = gates + (size_t)(row0 + ai * 128 + m * 16) * 8;
                        *(f32x4*)gp = acc[ai][0][m][0]; *(f32x4*)(gp + 4) = acc[ai][0][m][1];
                    }
            }
        }
    }
};

struct EpiAll {
    static constexpr bool PERM = true, AFTER_DRAIN = false;
    int mode; bf16_t* O; int ldc; int nstore; float* gates; int gate_pn; const float* res; const bf16_t* resb; float* out; float scale;
    __device__ __forceinline__ void operator()(const f32x4 (&acc)[2][2][4][2], const Unit& u, int wr, int wc, int fr, int fq) const {
        const int row0 = u.pm * 256 + wr * 64 + fr;
        if (mode == 0) {
            const int col0 = u.pn * 128 + wc * 32 + 8 * fq;
#pragma unroll
            for (int ai = 0; ai < 2; ++ai)
#pragma unroll
                for (int m = 0; m < 4; ++m) {
                    bf16_t* rowp = O + (size_t)(row0 + ai * 128 + m * 16) * FF + col0;
                    const f32x4 g0 = acc[ai][0][m][0], g1 = acc[ai][0][m][1], u0 = acc[ai][1][m][0], u1 = acc[ai][1][m][1];
                    u32x4 w;
                    w.x = pg8::cvt_pk_bf16(silu_f(g0[0]) * u0[0], silu_f(g0[1]) * u0[1]);
                    w.y = pg8::cvt_pk_bf16(silu_f(g0[2]) * u0[2], silu_f(g0[3]) * u0[3]);
                    w.z = pg8::cvt_pk_bf16(silu_f(g1[0]) * u1[0], silu_f(g1[1]) * u1[1]);
                    w.w = pg8::cvt_pk_bf16(silu_f(g1[2]) * u1[2], silu_f(g1[3]) * u1[3]);
                    *(u32x4*)rowp = w;
                }
        } else if (mode == 1) {
            const int col0 = u.pn * 256 + wc * 32 + 8 * fq;
#pragma unroll
            for (int ai = 0; ai < 2; ++ai)
#pragma unroll
                for (int m = 0; m < 4; ++m) {
                    const size_t off = (size_t)(row0 + ai * 128 + m * 16) * DM + col0;
#pragma unroll
                    for (int bj = 0; bj < 2; ++bj) {
                        f32x4 r0, r1;
                        if (resb) { const u32x4 rb = *(const u32x4*)(resb + off + bj * 128); r0 = (f32x4){LO16(rb.x), HI16(rb.x), LO16(rb.y), HI16(rb.y)}; r1 = (f32x4){LO16(rb.z), HI16(rb.z), LO16(rb.w), HI16(rb.w)}; }
                        else { r0 = *(const f32x4*)(res + off + bj * 128); r1 = *(const f32x4*)(res + off + bj * 128 + 4); }
                        *(f32x4*)(out + off + bj * 128) = r0 * ALPHA + acc[ai][bj][m][0] * scale;
                        *(f32x4*)(out + off + bj * 128 + 4) = r1 * ALPHA + acc[ai][bj][m][1] * scale;
                    }
                    if (m == 3 && !resb) asm volatile("" ::: "memory");
                }
        } else {
            if (u.pn < nstore) {
                const int col0 = u.pn * 256 + wc * 32 + 8 * fq;
#pragma unroll
                for (int ai = 0; ai < 2; ++ai)
#pragma unroll
                    for (int m = 0; m < 4; ++m) {
                        bf16_t* rowp = O + (size_t)(row0 + ai * 128 + m * 16) * ldc + col0;
#pragma unroll
                        for (int bj = 0; bj < 2; ++bj) {
                            const f32x4 v0 = acc[ai][bj][m][0], v1 = acc[ai][bj][m][1];
                            u32x4 w; w.x = pg8::cvt_pk_bf16(v0[0], v0[1]); w.y = pg8::cvt_pk_bf16(v0[2], v0[3]); w.z = pg8::cvt_pk_bf16(v1[0], v1[1]); w.w = pg8::cvt_pk_bf16(v1[2], v1[3]);
                            *(u32x4*)(rowp + bj * 128) = w;
                        }
                    }
            } else if (u.pn == gate_pn) {
                if (wc == 0 && fq == 0) {
#pragma unroll
                    for (int ai = 0; ai < 2; ++ai)
#pragma unroll
                        for (int m = 0; m < 4; ++m) {
                            float* gp = gates + (size_t)(row0 + ai * 128 + m * 16) * 8;
                            *(f32x4*)gp = acc[ai][0][m][0]; *(f32x4*)(gp + 4) = acc[ai][0][m][1];
                        }
                }
            }
        }
    }
};

__device__ __forceinline__ void tr_item(const float* colp4, int Ns, bf16_t* WT, int K, int r0, int k0, LAS float* scr, int lane) {
    f32x4 v[8];
#pragma unroll
    for (int i = 0; i < 8; ++i) { const int kk = (lane >> 3) + 8 * i; v[i] = colp4 ? *(const f32x4*)(colp4 + (size_t)(k0 + kk) * Ns) : (f32x4){0.f, 0.f, 0.f, 0.f}; }
#pragma unroll
    for (int i = 0; i < 8; ++i) { const int kk = (lane >> 3) + 8 * i; LAS float* d = scr + kk * 33 + 4 * (lane & 7); d[0] = v[i][0]; d[1] = v[i][1]; d[2] = v[i][2]; d[3] = v[i][3]; }
    asm volatile("s_waitcnt lgkmcnt(0)" ::: "memory");
    const int c = lane & 7;
#pragma unroll
    for (int j = 0; j < 4; ++j) { const int n = (lane >> 3) + 8 * j; const LAS float* s = scr + (8 * c) * 33 + n;
        u32x4 o; o.x = pk2(s[0], s[33]); o.y = pk2(s[2 * 33], s[3 * 33]); o.z = pk2(s[4 * 33], s[5 * 33]); o.w = pk2(s[6 * 33], s[7 * 33]);
        *(u32x4*)(WT + (size_t)(r0 + n) * K + k0 + 8 * c) = o; }
    asm volatile("s_waitcnt lgkmcnt(0)" ::: "memory");
}
__device__ __forceinline__ void cvt_rows(const float* src, bf16_t* dst, size_t n8, size_t gtid, size_t nthr) {
    for (size_t i = gtid; i < n8; i += nthr) { const f32x4 a = *(const f32x4*)(src + i * 8), b = *(const f32x4*)(src + i * 8 + 4);
        u32x4 w; w.x = pk2(a[0], a[1]); w.y = pk2(a[2], a[3]); w.z = pk2(b[0], b[1]); w.w = pk2(b[2], b[3]); *(u32x4*)(dst + i * 8) = w; }
}
__device__ __forceinline__ void prologue(const Params& p, LAS unsigned char* lds, int gw, int ngw, int wave, int lane, size_t gtid, size_t nthr) {
    LAS float* scr = (LAS float*)(lds + wave * 8704);
    unsigned char* ws = p.ws;
    constexpr int I_GU = 176 * 16, I_D = 32 * 44, I_KV = 16 * 16, I_O = 32 * 16, I_0 = 80 * 16, I_1 = 112 * 16;
    constexpr int NITEMS = 4 * I_GU + 4 * I_D + 2 * I_KV + 2 * I_O + I_0 + I_1;
    const int l31 = 4 * (lane & 7);
    for (int it = gw; it < NITEMS; it += ngw) {
        int r = it;
        if (r < 4 * I_GU) { const int m = r / I_GU; r -= m * I_GU; const int kb = r / 176, nb = r % 176, row = nb * 32 + l31, pn = row >> 8, bj = (row >> 7) & 1, j = row & 127;
            tr_item((bj ? p.wu : p.wg) + (size_t)m * 1024 * FF + 128 * pn + j, FF, (bf16_t*)(ws + OFF_WGU + m * SZ_WGU), 1024, nb * 32, kb * 64, scr, lane); continue; }
        r -= 4 * I_GU;
        if (r < 4 * I_D) { const int m = r / I_D; r -= m * I_D; const int kb = r >> 5, nb = r & 31, row = nb * 32 + l31;
            tr_item(p.wd + (size_t)m * FF * 1024 + row, 1024, (bf16_t*)(ws + OFF_WD + m * SZ_WD), FF, nb * 32, kb * 64, scr, lane); continue; }
        r -= 4 * I_D;
        if (r < 2 * I_KV) { const int m = r / I_KV; r -= m * I_KV; const int kb = r >> 4, nb = r & 15, row = nb * 32 + l31;
            tr_item(p.wkv + (size_t)m * 1024 * 512 + row, 512, (bf16_t*)(ws + OFF_WKV + m * SZ_WKV), 1024, nb * 32, kb * 64, scr, lane); continue; }
        r -= 2 * I_KV;
        if (r < 2 * I_O) { const int m = r / I_O; r -= m * I_O; const int kb = r >> 5, nb = r & 31, row = nb * 32 + l31;
            tr_item(p.wout + (size_t)m * 1024 * 1024 + row, 1024, (bf16_t*)(ws + OFF_WOUT + m * SZ_WOUT), 1024, nb * 32, kb * 64, scr, lane); continue; }
        r -= 2 * I_O;
        if (r < I_0) { const int kb = r / 80, nb = r % 80, row = nb * 32 + l31;
            tr_item(p.win0 + row, LDU0, (bf16_t*)(ws + OFF_WIN0), 1024, nb * 32, kb * 64, scr, lane); continue; }
        r -= I_0;
        { const int kb = r / 112, nb = r % 112, row = nb * 32 + l31;
          const int col = row < 3072 ? row : (row < 3328 ? row + 8 : (row < 3336 ? row - 256 : -1));
          tr_item(col >= 0 ? p.win1 + col : (const float*)nullptr, NS1, (bf16_t*)(ws + OFF_WIN1), 1024, nb * 32, kb * 64, scr, lane); }
    }
    cvt_rows(p.x, (bf16_t*)(ws + OFF_XB), (size_t)NTOK * DM / 8, gtid, nthr);
    cvt_rows(p.mem, (bf16_t*)(ws + OFF_MEMB), (size_t)2048 * DM / 8, gtid, nthr);
}

__device__ __forceinline__ void ln_phase(const float* Xin, float* Xout, bf16_t* XB, const float* g, const float* b, bool wf32, bool wbf, int gw, int ngw, int lane) {
    f32x4 gv[4], bv[4];
#pragma unroll
    for (int j = 0; j < 4; ++j) { gv[j] = ((const f32x4*)g)[lane + 64 * j]; bv[j] = ((const f32x4*)b)[lane + 64 * j]; }
    for (int row0 = gw * 4; row0 < NTOK; row0 += ngw * 4) {
        f32x4 v[4][4]; float s[4], s2[4];
#pragma unroll
        for (int r = 0; r < 4; ++r) { const f32x4* xr = (const f32x4*)(Xin + (size_t)(row0 + r) * DM) + lane;
#pragma unroll
            for (int j = 0; j < 4; ++j) v[r][j] = xr[64 * j]; }
#pragma unroll
        for (int r = 0; r < 4; ++r) { s[r] = 0.f;
#pragma unroll
            for (int j = 0; j < 4; ++j) s[r] += (v[r][j][0] + v[r][j][1]) + (v[r][j][2] + v[r][j][3]); }
#pragma unroll
        for (int o = 1; o < 64; o <<= 1)
#pragma unroll
            for (int r = 0; r < 4; ++r) s[r] += __shfl_xor(s[r], o);
#pragma unroll
        for (int r = 0; r < 4; ++r) { const float mean = s[r] * (1.f / DM); s2[r] = 0.f;
#pragma unroll
            for (int j = 0; j < 4; ++j) { v[r][j] = v[r][j] - mean; s2[r] += (v[r][j][0] * v[r][j][0] + v[r][j][1] * v[r][j][1]) + (v[r][j][2] * v[r][j][2] + v[r][j][3] * v[r][j][3]); } }
#pragma unroll
        for (int o = 1; o < 64; o <<= 1)
#pragma unroll
            for (int r = 0; r < 4; ++r) s2[r] += __shfl_xor(s2[r], o);
#pragma unroll
        for (int r = 0; r < 4; ++r) {
            const float rstd = 1.0f / sqrtf(s2[r] * (1.f / DM) + LN_EPS);
            f32x4* xo = (f32x4*)(Xout + (size_t)(row0 + r) * DM) + lane;
            u32x2* bo = (u32x2*)(XB + (size_t)(row0 + r) * DM) + lane;
#pragma unroll
            for (int j = 0; j < 4; ++j) { const f32x4 y = v[r][j] * rstd * gv[j] + bv[j]; if (wf32) xo[64 * j] = y; if (wbf) { u32x2 w; w.x = pk2(y[0], y[1]); w.y = pk2(y[2], y[3]); bo[64 * j] = w; } }
        }
    }
}

__device__ __forceinline__ void conv_phase(const bf16_t* U, const float* cw, bf16_t* MIX, size_t gtid, size_t nthr) {
    for (size_t i = gtid; i < (size_t)NTOK * 96; i += nthr) {
        const int tok = (int)(i / 96), cgi = (int)(i % 96), pos = tok & (SEQ - 1);
        const bf16_t* up = U + (size_t)tok * LDU0 + cgi * 8;
        const u32x4 bg = *(const u32x4*)up;
        float acc[8];
#pragma unroll
        for (int e = 0; e < 8; ++e) acc[e] = 0.f;
#pragma unroll
        for (int j = 0; j < 3; ++j) {
            if (pos - j >= 0) {
                const u32x4 c = *(const u32x4*)(up - (size_t)j * LDU0 + 768), xi = *(const u32x4*)(up - (size_t)j * LDU0 + 1536);
                const f32x4 w0 = *(const f32x4*)(cw + (2 - j) * 768 + cgi * 8), w1 = *(const f32x4*)(cw + (2 - j) * 768 + cgi * 8 + 4);
                acc[0] += w0[0] * LO16(c.x) * LO16(xi.x); acc[1] += w0[1] * HI16(c.x) * HI16(xi.x);
                acc[2] += w0[2] * LO16(c.y) * LO16(xi.y); acc[3] += w0[3] * HI16(c.y) * HI16(xi.y);
                acc[4] += w1[0] * LO16(c.z) * LO16(xi.z); acc[5] += w1[1] * HI16(c.z) * HI16(xi.z);
                acc[6] += w1[2] * LO16(c.w) * LO16(xi.w); acc[7] += w1[3] * HI16(c.w) * HI16(xi.w);
            }
        }
        u32x4 o;
        o.x = pk2(LO16(bg.x) * acc[0], HI16(bg.x) * acc[1]); o.y = pk2(LO16(bg.y) * acc[2], HI16(bg.y) * acc[3]);
        o.z = pk2(LO16(bg.z) * acc[4], HI16(bg.z) * acc[5]); o.w = pk2(LO16(bg.w) * acc[6], HI16(bg.w) * acc[7]);
        *(u32x4*)(MIX + (size_t)tok * DM + cgi * 8) = o;
    }
}

__device__ __forceinline__ void xattn_phase(LAS unsigned char* lds, const bf16_t* U, int ldu, int qoff, const bf16_t* KV, bf16_t* MIX, int tid) {
    const int wave = tid >> 6, lane = tid & 63, fr = lane & 15, fq = lane >> 4;
    LAS bf16_t* Ks = (LAS bf16_t*)lds;
    LAS bf16_t* Vt = Ks + 256 * 72;
    for (int item = blockIdx.x; item < 256; item += gridDim.x) {
        const int b = item >> 5, hd = (item >> 3) & 3, tc = item & 7;
        __syncthreads();
#pragma unroll
        for (int i = 0; i < 4; ++i) {
            const int id = tid + 512 * i, key = id >> 3, dc = id & 7;
            const bf16_t* src = KV + (size_t)(b * 256 + key) * 1024 + hd * 64 + dc * 8;
            const u32x4 kk = *(const u32x4*)src, vv = *(const u32x4*)(src + 256);
            *(LAS u32x4*)(Ks + key * 72 + dc * 8) = kk;
            const int kb = key >> 4, q4 = (key >> 2) & 3, e4 = key & 3, pos = (kb >> 1) * 32 + q4 * 8 + (kb & 1) * 4 + e4;
            LAS bf16_t* vd = Vt + (dc * 8) * 264 + pos;
            vd[0] = (bf16_t)(vv.x & 0xffffu); vd[264] = (bf16_t)(vv.x >> 16); vd[2 * 264] = (bf16_t)(vv.y & 0xffffu); vd[3 * 264] = (bf16_t)(vv.y >> 16);
            vd[4 * 264] = (bf16_t)(vv.z & 0xffffu); vd[5 * 264] = (bf16_t)(vv.z >> 16); vd[6 * 264] = (bf16_t)(vv.w & 0xffffu); vd[7 * 264] = (bf16_t)(vv.w >> 16);
        }
        __syncthreads();
#pragma unroll 1
        for (int tt = 0; tt < 4; ++tt) {
            asm volatile("" ::: "memory");
            const int tok0 = b * SEQ + tc * 512 + (wave * 4 + tt) * 16;
            const bf16_t* qp = U + (size_t)(tok0 + fr) * ldu + qoff + hd * 64 + fq * 8;
            const bf16x8 qf0 = *(const bf16x8*)qp, qf1 = *(const bf16x8*)(qp + 32);
            f32x4 s[16];
#pragma unroll
            for (int kb = 0; kb < 16; ++kb) {
                const LAS bf16_t* kp = Ks + (kb * 16 + fr) * 72 + fq * 8;
                f32x4 a = {0.f, 0.f, 0.f, 0.f};
                a = MFMA16(*(const LAS bf16x8*)kp, qf0, a);
                a = MFMA16(*(const LAS bf16x8*)(kp + 32), qf1, a);
                s[kb] = a;
            }
            float mx = -3.0e38f;
#pragma unroll
            for (int kb = 0; kb < 16; ++kb) mx = fmaxf(mx, fmaxf(fmaxf(s[kb][0], s[kb][1]), fmaxf(s[kb][2], s[kb][3])));
            mx = fmaxf(mx, __shfl_xor(mx, 16)); mx = fmaxf(mx, __shfl_xor(mx, 32));
            const float sc = 0.125f * 1.44269504089f; float sum = 0.f;
#pragma unroll
            for (int kb = 0; kb < 16; ++kb)
#pragma unroll
                for (int j = 0; j < 4; ++j) { const float pe = exp2f((s[kb][j] - mx) * sc); s[kb][j] = pe; sum += pe; }
            sum += __shfl_xor(sum, 16); sum += __shfl_xor(sum, 32);
            const float inv = 1.0f / sum;
            f32x4 o[4];
#pragma unroll
            for (int dn = 0; dn < 4; ++dn) o[dn] = (f32x4){0.f, 0.f, 0.f, 0.f};
#pragma unroll
            for (int ks = 0; ks < 8; ++ks) {
                u32x4 pw; pw.x = pk2(s[2 * ks][0], s[2 * ks][1]); pw.y = pk2(s[2 * ks][2], s[2 * ks][3]); pw.z = pk2(s[2 * ks + 1][0], s[2 * ks + 1][1]); pw.w = pk2(s[2 * ks + 1][2], s[2 * ks + 1][3]);
                const bf16x8 pf = __builtin_bit_cast(bf16x8, pw);
#pragma unroll
                for (int dn = 0; dn < 4; ++dn) o[dn] = MFMA16(*(const LAS bf16x8*)(Vt + (dn * 16 + fr) * 264 + ks * 32 + fq * 8), pf, o[dn]);
            }
            bf16_t* op = MIX + (size_t)(tok0 + fr) * DM + 768 + hd * 64 + fq * 4;
#pragma unroll
            for (int dn = 0; dn < 4; ++dn) { u32x2 w; w.x = pk2(o[dn][0] * inv, o[dn][1] * inv); w.y = pk2(o[dn][2] * inv, o[dn][3] * inv); *(u32x2*)(op + dn * 16) = w; }
        }
    }
}

__device__ __forceinline__ void m0_phase(const float* GATES, const float* bg, float* GB, float* GLI, float* GM, int gw, int ngw, int lane) {
    for (int item = gw; item < 2048; item += ngw) {
        const int bh = item >> 6, c = item & 63, b = bh >> 2, h = bh & 3;
        const size_t tok = (size_t)b * SEQ + c * 64 + lane;
        const float ip = GATES[tok * 8 + h] + bg[h], fp = GATES[tok * 8 + 4 + h] + bg[4 + h];
        const float lf = fminf(fp, 0.f) - log1pf(expf(-fabsf(fp)));
        float bc = lf;
#pragma unroll
        for (int o = 1; o < 64; o <<= 1) { const float t = __shfl_up(bc, o); if (lane >= o) bc += t; }
        const float bl = __shfl(bc, 63);
        const float mxl = wmax(bl - bc + ip);
        GB[(size_t)bh * SEQ + c * 64 + lane] = bc; GLI[(size_t)bh * SEQ + c * 64 + lane] = ip;
        if (lane == 0) { GM[6144 + item] = bl; GM[8192 + item] = mxl; }
    }
}
__device__ __forceinline__ void chunk_stab(const float* GM, int bh, int c, int lane, float& mst_c, float& mnew_c, float& dec_c) {
    const float bl = GM[6144 + bh * 64 + lane], ml = GM[8192 + bh * 64 + lane];
    float B = bl;
#pragma unroll
    for (int o = 1; o < 64; o <<= 1) { const float t = __shfl_up(B, o); if (lane >= o) B += t; }
    float pm = ml - B;
#pragma unroll
    for (int o = 1; o < 64; o <<= 1) { const float t = __shfl_up(pm, o); if (lane >= o) pm = fmaxf(pm, t); }
    const float mnew = B + fmaxf(0.f, pm);
    const float mprev = __shfl_up(mnew, 1);
    const float mst = lane == 0 ? 0.f : mprev;
    const float dec = expf(bl + mst - mnew);
    mst_c = __int_as_float(__builtin_amdgcn_readlane(__float_as_int(mst), c));
    mnew_c = __int_as_float(__builtin_amdgcn_readlane(__float_as_int(mnew), c));
    dec_c = __int_as_float(__builtin_amdgcn_readlane(__float_as_int(dec), c));
}

__device__ __forceinline__ void qk_conv8(const bf16_t* U, const float* qkw, size_t tok, int pos, int col, float (&r)[8]) {
#pragma unroll
    for (int e = 0; e < 8; ++e) r[e] = 0.f;
#pragma unroll
    for (int j = 0; j < 4; ++j) {
        if (pos - j >= 0) {
            const u32x4 v = *(const u32x4*)(U + (tok - j) * LDU1 + col);
            const f32x4 w0 = *(const f32x4*)(qkw + (3 - j) * 1536 + col), w1 = *(const f32x4*)(qkw + (3 - j) * 1536 + col + 4);
            r[0] += w0[0] * LO16(v.x); r[1] += w0[1] * HI16(v.x); r[2] += w0[2] * LO16(v.y); r[3] += w0[3] * HI16(v.y);
            r[4] += w1[0] * LO16(v.z); r[5] += w1[1] * HI16(v.z); r[6] += w1[2] * LO16(v.w); r[7] += w1[3] * HI16(v.w);
        }
    }
#pragma unroll
    for (int e = 0; e < 8; ++e) r[e] = silu_f(r[e]);
}

__device__ __forceinline__ void m1_phase(LAS unsigned char* lds, const bf16_t* U, const float* qkw, const float* GB, const float* GLI, const float* GM, float* GMW, bf16_t* CBUF, float* NBUF, int tid) {
    const int wave = tid >> 6, lane = tid & 63, fr = lane & 15, fq = lane >> 4;
    LAS bf16_t* KT = (LAS bf16_t*)lds;
    LAS bf16_t* VT = KT + 192 * 72;
    for (int item = blockIdx.x; item < 2048; item += gridDim.x) {
        const int bh = item >> 6, c = item & 63, b = bh >> 2, h = bh & 3;
        const size_t tok0 = (size_t)b * SEQ + c * 64;
        __syncthreads();
        {
            const int s = tid & 63, g0 = tid >> 6;
            const size_t gi = (size_t)bh * SEQ + c * 64;
            float mst_c, mnew_c, dec_c; chunk_stab(GM, bh, c, lane, mst_c, mnew_c, dec_c);
            if (tid == 0) { GMW[bh * 64 + c] = mst_c; GMW[2048 + bh * 64 + c] = mnew_c; GMW[4096 + bh * 64 + c] = dec_c; }
            const float wk = __expf(GB[gi + 63] - GB[gi + s] + GLI[gi + s] - mnew_c) * RS192;
#pragma unroll
            for (int it = 0; it < 3; ++it) {
                const int g = g0 + 8 * it, ch = h * 192 + g * 8;
                float kv[8];
                qk_conv8(U, qkw, tok0 + s, c * 64 + s, 768 + ch, kv);
                const u32x4 vv = *(const u32x4*)(U + (tok0 + s) * LDU1 + 1536 + ch);
                LAS bf16_t* kd = KT + (g * 8) * 72 + s; LAS bf16_t* vd = VT + (g * 8) * 72 + s;
#pragma unroll
                for (int e = 0; e < 8; ++e) kd[e * 72] = (bf16_t)f2bf(kv[e] * wk);
                vd[0] = (bf16_t)(vv.x & 0xffffu); vd[72] = (bf16_t)(vv.x >> 16); vd[2 * 72] = (bf16_t)(vv.y & 0xffffu); vd[3 * 72] = (bf16_t)(vv.y >> 16);
                vd[4 * 72] = (bf16_t)(vv.z & 0xffffu); vd[5 * 72] = (bf16_t)(vv.z >> 16); vd[6 * 72] = (bf16_t)(vv.w & 0xffffu); vd[7 * 72] = (bf16_t)(vv.w >> 16);
            }
        }
        __syncthreads();
        if (tid < 192) { float sm = 0.f;
#pragma unroll 8
            for (int s = 0; s < 64; ++s) sm += bf2f(KT[tid * 72 + s]);
            NBUF[(size_t)(bh * 64 + c) * 192 + tid] = sm; }
        bf16_t* cb = CBUF + (size_t)(bh * 64 + c) * 36864;
#pragma unroll 2
        for (int i = 0; i < 18; ++i) {
            const int idx = wave * 18 + i, dkt = idx / 12, dvt = idx % 12;
            const LAS bf16_t* ap = KT + (dkt * 16 + fr) * 72 + fq * 8; const LAS bf16_t* bp = VT + (dvt * 16 + fr) * 72 + fq * 8;
            f32x4 a = {0.f, 0.f, 0.f, 0.f};
            a = MFMA16(*(const LAS bf16x8*)ap, *(const LAS bf16x8*)bp, a);
            a = MFMA16(*(const LAS bf16x8*)(ap + 32), *(const LAS bf16x8*)(bp + 32), a);
            u32x2 w; w.x = pk2(a[0], a[1]); w.y = pk2(a[2], a[3]);
            *(u32x2*)(cb + (size_t)(dvt * 16 + fr) * 192 + dkt * 16 + fq * 4) = w;
        }
    }
}

__device__ __forceinline__ void m2_phase(bf16_t* CBUF, float* NBUF, const float* GM, int tidx) {
    for (int i = (int)blockIdx.x * 288 + tidx; tidx < 288 && i < 32 * 2304; i += (int)gridDim.x * 288) {
        const int bh = i / 2304, e = i % 2304;
        bf16_t* ptr = CBUF + (size_t)bh * 64 * 36864 + e * 16;
        const float* dec = GM + 4096 + bh * 64;
        float r[16];
#pragma unroll
        for (int k = 0; k < 16; ++k) r[k] = 0.f;
#pragma unroll 4
        for (int c = 0; c < 64; ++c) {
            const u32x4 d0 = *(const u32x4*)(ptr + (size_t)c * 36864), d1 = *(const u32x4*)(ptr + (size_t)c * 36864 + 8);
            u32x4 w0, w1;
            w0.x = pk2(r[0], r[1]); w0.y = pk2(r[2], r[3]); w0.z = pk2(r[4], r[5]); w0.w = pk2(r[6], r[7]);
            w1.x = pk2(r[8], r[9]); w1.y = pk2(r[10], r[11]); w1.z = pk2(r[12], r[13]); w1.w = pk2(r[14], r[15]);
            *(u32x4*)(ptr + (size_t)c * 36864) = w0; *(u32x4*)(ptr + (size_t)c * 36864 + 8) = w1;
            const float dc = dec[c];
            r[0] = dc * r[0] + LO16(d0.x); r[1] = dc * r[1] + HI16(d0.x); r[2] = dc * r[2] + LO16(d0.y); r[3] = dc * r[3] + HI16(d0.y);
            r[4] = dc * r[4] + LO16(d0.z); r[5] = dc * r[5] + HI16(d0.z); r[6] = dc * r[6] + LO16(d0.w); r[7] = dc * r[7] + HI16(d0.w);
            r[8] = dc * r[8] + LO16(d1.x); r[9] = dc * r[9] + HI16(d1.x); r[10] = dc * r[10] + LO16(d1.y); r[11] = dc * r[11] + HI16(d1.y);
            r[12] = dc * r[12] + LO16(d1.z); r[13] = dc * r[13] + HI16(d1.z); r[14] = dc * r[14] + LO16(d1.w); r[15] = dc * r[15] + HI16(d1.w);
        }
    }
    if (tidx >= 288 && tidx < 312) {
        for (int i = (int)blockIdx.x * 24 + (tidx - 288); i < 32 * 192; i += (int)gridDim.x * 24) {
            const int bh = i / 192, e = i % 192;
            float* ptr = NBUF + (size_t)bh * 64 * 192 + e;
            const float* dec = GM + 4096 + bh * 64;
            float r = 0.f;
            for (int c = 0; c < 64; ++c) { const float d = ptr[c * 192]; ptr[c * 192] = r; r = dec[c] * r + d; }
        }
    }
}

__device__ __forceinline__ void m3_phase(LAS unsigned char* lds, const bf16_t* U, const float* qkw, const float* hng, const float* GB, const float* GLI, const float* GM,
                                         const bf16_t* CBUF, const float* NBUF, bf16_t* MIX, int tid) {
    const int wave = tid >> 6, lane = tid & 63, fr = lane & 15, fq = lane >> 4;
    LAS bf16_t* Qs = (LAS bf16_t*)lds;
    LAS bf16_t* Ks = (LAS bf16_t*)(lds + 25600);
    LAS bf16_t* VT = (LAS bf16_t*)(lds + 51200);
    LAS bf16_t* CT = (LAS bf16_t*)(lds + 78848);
    LAS float* Hs = (LAS float*)(lds + 78848);
    LAS float* nS = (LAS float*)(lds + 155648);
    LAS float* bcS = nS + 192; LAS float* liS = bcS + 64; LAS float* mtS = liS + 64; LAS float* winS = mtS + 64; LAS float* qnS = winS + 64; LAS float* denP = qnS + 64;
    LAS bf16_t* Ps = Ks;
    for (int item = blockIdx.x; item < 2048; item += gridDim.x) {
        const int bh = item >> 6, c = item & 63, b = bh >> 2, h = bh & 3;
        const size_t tok0 = (size_t)b * SEQ + c * 64;
        __syncthreads();
#ifdef M3_DUP_STAGE
#pragma unroll 1
        for (int rep_ = 0; rep_ < 2; ++rep_) { if (rep_) { asm volatile("s_waitcnt vmcnt(0)" ::: "memory"); __syncthreads(); }
#else
        {
#endif
        {
            const bf16_t* cb = CBUF + (size_t)(bh * 64 + c) * 36864;
#pragma unroll
            for (int i = 0; i < 9; ++i) { const int P = tid + 512 * i, row = P / 24, slot = P % 24, chk = slot ^ ((row >> 1) & 7);
                __builtin_amdgcn_global_load_lds((const unsigned*)(cb + (size_t)row * 192 + chk * 8), (LAS unsigned*)((LAS unsigned char*)CT + (wave * 64 + 512 * i) * 16), 16, 0, 0); }
        }
        if (tid < 384) {
            const int g = tid % 24, r = tid / 24, ch = h * 192 + g * 8;
#pragma unroll 1
            for (int qk = 0; qk < 2; ++qk) {
                const int col = qk * 768 + ch; const float scl = qk ? RS192 : 1.0f; LAS bf16_t* dst = qk ? Ks : Qs;
                u32x4 rw[7];
#pragma unroll
                for (int i = 0; i < 7; ++i) {
                    const int sp = 4 * r - 3 + i;
                    if (c * 64 + sp >= 0) rw[i] = *(const u32x4*)(U + (size_t)((long)tok0 + sp) * LDU1 + col); else rw[i] = (u32x4){0u, 0u, 0u, 0u};
                }
                f32x4 wv[4][2];
#pragma unroll
                for (int j = 0; j < 4; ++j) { wv[j][0] = *(const f32x4*)(qkw + j * 1536 + col); wv[j][1] = *(const f32x4*)(qkw + j * 1536 + col + 4); }
#pragma unroll
                for (int si = 0; si < 4; ++si) {
                    float v[8];
#pragma unroll
                    for (int e = 0; e < 8; ++e) v[e] = 0.f;
#pragma unroll
                    for (int j = 0; j < 4; ++j) {
                        const u32x4 a = rw[si + j];
                        v[0] += wv[j][0][0] * LO16(a.x); v[1] += wv[j][0][1] * HI16(a.x); v[2] += wv[j][0][2] * LO16(a.y); v[3] += wv[j][0][3] * HI16(a.y);
                        v[4] += wv[j][1][0] * LO16(a.z); v[5] += wv[j][1][1] * HI16(a.z); v[6] += wv[j][1][2] * LO16(a.w); v[7] += wv[j][1][3] * HI16(a.w);
                    }
#pragma unroll
                    for (int e = 0; e < 8; ++e) v[e] = silu_f(v[e]) * scl;
                    u32x4 w; w.x = pk2(v[0], v[1]); w.y = pk2(v[2], v[3]); w.z = pk2(v[4], v[5]); w.w = pk2(v[6], v[7]);
                    *(LAS u32x4*)(dst + (4 * r + si) * 200 + g * 8) = w;
                }
                asm volatile("" ::: "memory");
            }
        }
        {
            const int s = tid & 63, g0 = tid >> 6;
#pragma unroll
            for (int it = 0; it < 3; ++it) {
                const int g = g0 + 8 * it, ch = h * 192 + g * 8;
                const u32x4 vv = *(const u32x4*)(U + (tok0 + s) * LDU1 + 1536 + ch);
                LAS bf16_t* vd = VT + (g * 8) * 72 + s;
                vd[0] = (bf16_t)(vv.x & 0xffffu); vd[72] = (bf16_t)(vv.x >> 16); vd[2 * 72] = (bf16_t)(vv.y & 0xffffu); vd[3 * 72] = (bf16_t)(vv.y >> 16);
                vd[4 * 72] = (bf16_t)(vv.z & 0xffffu); vd[5 * 72] = (bf16_t)(vv.z >> 16); vd[6 * 72] = (bf16_t)(vv.w & 0xffffu); vd[7 * 72] = (bf16_t)(vv.w >> 16);
            }
        }
        {
            if (tid < 192) nS[tid] = NBUF[(size_t)(bh * 64 + c) * 192 + tid];
            if (tid < 64) { bcS[tid] = GB[(size_t)bh * SEQ + c * 64 + tid]; liS[tid] = GLI[(size_t)bh * SEQ + c * 64 + tid]; }
        }
        }
        const float mst = GM[bh * 64 + c];
        asm volatile("s_waitcnt vmcnt(0)" ::: "memory");
        __syncthreads();
        if (wave == 0) {
            const float bc = bcS[lane]; float pm = liS[lane] - bc;
#pragma unroll
            for (int o = 1; o < 64; o <<= 1) { const float t = __shfl_up(pm, o); if (lane >= o) pm = fmaxf(pm, t); }
            const float mt = bc + fmaxf(mst, pm);
            mtS[lane] = mt; winS[lane] = __expf(bc + mst - mt);
        }
        {
            const int t = tid >> 3, part = tid & 7; float sm = 0.f;
#pragma unroll 8
            for (int d = 0; d < 24; ++d) sm += bf2f(Qs[t * 200 + part * 24 + d]) * nS[part * 24 + d];
            sm += __shfl_xor(sm, 1); sm += __shfl_xor(sm, 2); sm += __shfl_xor(sm, 4);
            if (part == 0) qnS[t] = sm;
        }
        f32x4 sacc[2];
#pragma unroll
        for (int i = 0; i < 2; ++i) {
            const int tile = wave * 2 + i, tt = tile >> 2, st = tile & 3;
            const LAS bf16_t* ap = Qs + (tt * 16 + fr) * 200 + fq * 8; const LAS bf16_t* bp = Ks + (st * 16 + fr) * 200 + fq * 8;
            f32x4 a = {0.f, 0.f, 0.f, 0.f};
#pragma unroll
            for (int ks = 0; ks < 6; ++ks) a = MFMA16(*(const LAS bf16x8*)(ap + ks * 32), *(const LAS bf16x8*)(bp + ks * 32), a);
            sacc[i] = a;
        }
        __syncthreads();
#pragma unroll
        for (int i = 0; i < 2; ++i) {
            const int tile = wave * 2 + i, tt = tile >> 2, st = tile & 3, s = st * 16 + fr;
            const float gs = liS[s] - bcS[s];
#pragma unroll
            for (int j = 0; j < 4; ++j) {
                const int t = tt * 16 + fq * 4 + j;
                const float w = (s <= t) ? __expf(bcS[t] + gs - mtS[t]) : 0.f;
                const float scv = sacc[i][j] * w;
                Ps[t * 72 + s] = (bf16_t)f2bf(scv);
                float rs = scv; rs += __shfl_xor(rs, 1); rs += __shfl_xor(rs, 2); rs += __shfl_xor(rs, 4); rs += __shfl_xor(rs, 8);
                if (fr == 0) denP[t * 4 + st] = rs;
            }
        }
        __syncthreads();
        u32x4 ogc[3];
#pragma unroll
        for (int i = 0; i < 3; ++i) { const int id = lane + 64 * i, orow = id / 24, ochk = id % 24;
            ogc[i] = *(const u32x4*)(U + (tok0 + wave * 8 + orow) * LDU1 + 2304 + h * 192 + ochk * 8); }
        const float hg0 = hng[h * 192 + lane], hg1 = hng[h * 192 + lane + 64], hg2 = hng[h * 192 + lane + 128];
        f32x4 hv[6];
        {
            const int tt = wave >> 1, dvt0 = (wave & 1) * 6;
            const LAS bf16_t* pp = Ps + (tt * 16 + fr) * 72 + fq * 8; const LAS bf16_t* qp = Qs + (tt * 16 + fr) * 200 + fq * 8;
            const bf16x8 pa0 = *(const LAS bf16x8*)pp, pa1 = *(const LAS bf16x8*)(pp + 32);
            bf16x8 qa[6];
#pragma unroll
            for (int ks = 0; ks < 6; ++ks) qa[ks] = *(const LAS bf16x8*)(qp + ks * 32);
            float win[4], rden[4];
#pragma unroll
            for (int j = 0; j < 4; ++j) { const int t = tt * 16 + fq * 4 + j; win[j] = winS[t];
                const float den = (denP[t * 4] + denP[t * 4 + 1]) + (denP[t * 4 + 2] + denP[t * 4 + 3]) + win[j] * qnS[t];
                rden[j] = 1.0f / fmaxf(fabsf(den), __expf(-mtS[t])); }
#pragma unroll
            for (int i = 0; i < 6; ++i) {
                const int dvt = dvt0 + i;
                const LAS bf16_t* vp = VT + (dvt * 16 + fr) * 72 + fq * 8; const LAS bf16_t* cp = CT + (dvt * 16 + fr) * 192; const int csw = (fr >> 1) & 7;
                f32x4 ia = {0.f, 0.f, 0.f, 0.f}, ie = {0.f, 0.f, 0.f, 0.f};
                ia = MFMA16(pa0, *(const LAS bf16x8*)vp, ia); ia = MFMA16(pa1, *(const LAS bf16x8*)(vp + 32), ia);
#pragma unroll
                for (int ks = 0; ks < 6; ++ks) ie = MFMA16(qa[ks], *(const LAS bf16x8*)(cp + ((ks * 4 + fq) ^ csw) * 8), ie);
#pragma unroll
                for (int j = 0; j < 4; ++j) hv[i][j] = (ia[j] + win[j] * ie[j]) * rden[j];
            }
        }
        __syncthreads();
        {
            const int tt = wave >> 1, dvt0 = (wave & 1) * 6;
#pragma unroll
            for (int i = 0; i < 6; ++i)
#pragma unroll
                for (int j = 0; j < 4; ++j) Hs[(tt * 16 + fq * 4 + j) * 196 + (dvt0 + i) * 16 + fr] = hv[i][j];
        }
        __syncthreads();
#ifdef M3_DUP_HN
#pragma unroll 1
        for (int rep_ = 0; rep_ < 2; ++rep_)
#endif
        {
            LAS bf16_t* osc = Qs + wave * 1536;
#pragma unroll
            for (int i = 0; i < 3; ++i) { const int id = lane + 64 * i, orow = id / 24, ochk = id % 24; *(LAS u32x4*)(osc + orow * 192 + ochk * 8) = ogc[i]; }
            asm volatile("s_waitcnt lgkmcnt(0)" ::: "memory");
#pragma unroll 1
            for (int rb = 0; rb < 2; ++rb) {
                float x[4][3];
#pragma unroll
                for (int r = 0; r < 4; ++r) { const int t = wave * 8 + rb * 4 + r; x[r][0] = Hs[t * 196 + lane]; x[r][1] = Hs[t * 196 + lane + 64]; x[r][2] = Hs[t * 196 + lane + 128]; }
                float mean[4], var[4];
#pragma unroll
                for (int r = 0; r < 4; ++r) mean[r] = x[r][0] + x[r][1] + x[r][2];
#pragma unroll
                for (int o = 1; o < 64; o <<= 1)
#pragma unroll
                    for (int r = 0; r < 4; ++r) mean[r] += __shfl_xor(mean[r], o);
#pragma unroll
                for (int r = 0; r < 4; ++r) { mean[r] *= (1.f / 192.f); x[r][0] -= mean[r]; x[r][1] -= mean[r]; x[r][2] -= mean[r]; var[r] = x[r][0] * x[r][0] + x[r][1] * x[r][1] + x[r][2] * x[r][2]; }
#pragma unroll
                for (int o = 1; o < 64; o <<= 1)
#pragma unroll
                    for (int r = 0; r < 4; ++r) var[r] += __shfl_xor(var[r], o);
#pragma unroll
                for (int r = 0; r < 4; ++r) { const int rr = rb * 4 + r, t = wave * 8 + rr;
                    const float rstd = 1.0f / sqrtf(var[r] * (1.f / 192.f) + LN_EPS);
                    bf16_t* mp = MIX + (tok0 + t) * DM + h * 192 + lane;
                    mp[0] = (bf16_t)f2bf(sigmoid_f(bf2f(osc[rr * 192 + lane])) * (x[r][0] * rstd * hg0));
                    mp[64] = (bf16_t)f2bf(sigmoid_f(bf2f(osc[rr * 192 + lane + 64])) * (x[r][1] * rstd * hg1));
                    mp[128] = (bf16_t)f2bf(sigmoid_f(bf2f(osc[rr * 192 + lane + 128])) * (x[r][2] * rstd * hg2)); }
            }
        }
    }
}

#define XB_TMO      128
#define XB_XCNT(j)  (256  + 64 * (j))
#define XB_XSUB(j)  (1280 + 64 * (j))
#define XB_XGEN(j)  (2304 + 64 * (j))
#define XB_TOP      3328
#define XB_TOPGEN   3392
#define XCD_BAR_WORDS 3456
#define XB_SPIN_CAP (1u << 18)
__device__ __forceinline__ unsigned xb_ld(unsigned* p)              { return __hip_atomic_load(p, __ATOMIC_RELAXED, __HIP_MEMORY_SCOPE_AGENT); }
__device__ __forceinline__ unsigned xb_add(unsigned* p, unsigned v) { return __hip_atomic_fetch_add(p, v, __ATOMIC_RELAXED, __HIP_MEMORY_SCOPE_AGENT); }
__device__ __forceinline__ unsigned xb_xcc_id() { return (unsigned)__builtin_amdgcn_s_getreg((3 << 11) | 20) & 0xFu; }
#define XB_SPIN(cond, bar) do { unsigned _sp = 0; while (cond) { __builtin_amdgcn_s_sleep(1); \
    if ((++_sp & 255u) == 0u) { if (xb_ld(&(bar)[XB_TMO])) break; if (_sp > XB_SPIN_CAP) { atomicAdd(&(bar)[XB_TMO], 1u); break; } } } } while (0)
__device__ __forceinline__ void xcd_barrier_complete(unsigned* bar, unsigned x, unsigned& nloc, unsigned& nx) {
    const unsigned G = gridDim.x * gridDim.y * gridDim.z;
    unsigned sum, cnt, mine, sp = 0u;
    for (;;) {
        sum = 0u; cnt = 0u; mine = 0u;
#pragma unroll
        for (unsigned j = 0; j < 16; ++j) { const unsigned c = xb_ld(&bar[XB_XCNT(j)]); sum += c; cnt += (c > 0u) ? 1u : 0u; mine = (j == x) ? c : mine; }
        if (sum == G) break;
        __builtin_amdgcn_s_sleep(1);
        if ((++sp & 255u) == 0u) { if (xb_ld(&bar[XB_TMO])) break; if (sp > XB_SPIN_CAP) { atomicAdd(&bar[XB_TMO], 1u); break; } }
    }
    nloc = mine > 0u ? mine : 1u; nx = cnt > 0u ? cnt : 1u;
}
__device__ __forceinline__ void xcd_barrier(unsigned* bar, volatile LAS unsigned* st) {
    asm volatile("s_waitcnt vmcnt(0)" ::: "memory");
    __syncthreads();
    if (threadIdx.x == 0) {
        __builtin_amdgcn_s_waitcnt(0);
        const unsigned x = xb_xcc_id();
        unsigned nloc = st[0], nx = st[1];
        if (nloc == 0u) { xcd_barrier_complete(bar, x, nloc, nx); st[0] = nloc; st[1] = nx; }
        const unsigned old = xb_add(&bar[XB_XSUB(x)], 1u);
        const unsigned gen = old / nloc;
        if (old + 1u == (gen + 1u) * nloc) {
            __builtin_amdgcn_fence(__ATOMIC_RELEASE, "agent");
            asm volatile("s_waitcnt vmcnt(0)" ::: "memory");
            const unsigned og = xb_add(&bar[XB_TOP], 1u);
            const unsigned tg = og / nx;
            if (og + 1u == (tg + 1u) * nx) xb_add(&bar[XB_TOPGEN], 1u);
            else XB_SPIN(xb_ld(&bar[XB_TOPGEN]) == tg, bar);
            __builtin_amdgcn_fence(__ATOMIC_ACQUIRE, "agent");
            xb_add(&bar[XB_XGEN(x)], 1u);
            asm volatile("s_waitcnt vmcnt(0)" ::: "memory");
        } else {
            XB_SPIN(xb_ld(&bar[XB_XGEN(x)]) == gen, bar);
            __builtin_amdgcn_fence(__ATOMIC_ACQUIRE, "agent");
            asm volatile("s_waitcnt vmcnt(0)" ::: "memory");
        }
    }
    __syncthreads();
}

__device__ __forceinline__ int opaque_tid() { int t = threadIdx.x; asm volatile("" : "+v"(t)); return t; }
__global__ void __launch_bounds__(512, 2) fwd_kernel(Params p) {
    extern __shared__ __attribute__((aligned(16))) unsigned char shm[];
    LAS unsigned char* lds = (LAS unsigned char*)shm;
    cg::grid_group grid = cg::this_grid();
#define tid (opaque_tid())
#define wave (__builtin_amdgcn_readfirstlane(opaque_tid() >> 6))
#define lane (opaque_tid() & 63)
#define gw ((int)blockIdx.x * 8 + wave)
#define ngw ((int)gridDim.x * 8)
#define gtid ((size_t)blockIdx.x * 512 + opaque_tid())
#define nthr ((size_t)gridDim.x * 512)
    unsigned char* ws = p.ws;
    bf16_t* XB = (bf16_t*)(ws + OFF_XB); bf16_t* HU = (bf16_t*)(ws + OFF_HU); bf16_t* CBUF = (bf16_t*)(ws + OFF_CBUF);
    bf16_t* MEMB = (bf16_t*)(ws + OFF_MEMB); float* GATES = (float*)(ws + OFF_GATES); float* NBUF = (float*)(ws + OFF_NBUF);
    float* GB = (float*)(ws + OFF_GB); float* GLI = (float*)(ws + OFF_GLI); float* GM = (float*)(ws + OFF_GM);
    float* X = p.out;
    unsigned* bar = (unsigned*)(ws + OFF_BAR);
    volatile LAS unsigned* bst = (volatile LAS unsigned*)(lds + LDS_MAIN);
    if (threadIdx.x == 0) { bst[0] = 0u; bst[1] = 0u; (void)xb_add(&bar[XB_XCNT(xb_xcc_id())], 1u); }
    __syncthreads();
    if (gridDim.x == 0x7fffffffu) grid.sync();
#define GRID_SYNC() xcd_barrier(bar, bst)

#ifndef NO_PRO
#pragma unroll 1
    for (int i = 0; i < EXTRA_SYNC; ++i) GRID_SYNC();
    if (DUP_PRO) { prologue(p, lds, gw, ngw, wave, lane, gtid, nthr); GRID_SYNC(); }
    prologue(p, lds, gw, ngw, wave, lane, gtid, nthr);
#endif
    GRID_SYNC();

#pragma unroll 1
    for (int l = 0; l < 2; ++l) {
#pragma unroll 1
#ifdef DUP_M12
        for (int sti = 0; sti < 14 + (l == 1 ? 2 : 0); ++sti) {
            const int st = (l == 1 && sti > 7) ? sti - 2 : sti;
#else
        for (int sti = 0; sti < 14 + ((DUP_ST >= 0 && (DUP_L < 0 || DUP_L == l)) ? 1 : 0); ++sti) {
            const int st = (DUP_ST >= 0 && (DUP_L < 0 || DUP_L == l) && sti > DUP_ST) ? sti - 1 : sti;
#endif
            if (l == 0 && st >= 6 && st <= 8) continue;
            bf16_t* MEMKV = (bf16_t*)(ws + OFF_MEMKV) + l * 512;
            if (l == 1 && st == 3) continue;
            const int gk = (st == 0 || st == 11) ? 0 : (st == 1 || st == 12) ? 1 : st == 3 ? 2 : st == 4 ? 3 : st == 9 ? 4 : -1;
            if (gk >= 0) {
#ifndef NO_G1
                const int m = l * 2 + (st >= 11 ? 1 : 0);
                pg8::Gemm g; EpiAll E;
                E.O = HU; E.ldc = FF; E.nstore = 0; E.gates = GATES; E.gate_pn = -1; E.res = X; E.resb = nullptr; E.out = X; E.scale = 1.0f;
                if (gk == 0) { g.A = XB; g.Bt = (const bf16_t*)(ws + OFF_WGU + m * SZ_WGU); g.M = NTOK; g.N = 2 * FF; g.K = DM; E.mode = 0; }
                else if (gk == 1) { g.A = HU; g.Bt = (const bf16_t*)(ws + OFF_WD + m * SZ_WD); g.M = NTOK; g.N = DM; g.K = FF; E.mode = 1; E.res = p.x; E.resb = (l == 0 && st == 1) ? (const bf16_t*)nullptr : XB; E.scale = 0.5f; }
                else if (gk == 2) { g.A = MEMB; g.Bt = (const bf16_t*)(ws + OFF_WKV + l * SZ_WKV); g.M = 2048; g.N = 1024; g.K = DM; E.mode = 2; E.O = MEMKV; E.ldc = 1024; E.nstore = 4; }
                else if (gk == 3) { g.A = XB; g.Bt = (const bf16_t*)(ws + (l == 0 ? OFF_WIN0 : OFF_WIN1)); g.M = NTOK; g.N = (l == 0 ? LDU0 : NIN1P); g.K = DM; E.mode = 2; E.ldc = (l == 0 ? LDU0 : LDU1); E.nstore = (l == 0 ? 10 : 13); E.gate_pn = (l == 0 ? -1 : 13); }
                else { g.A = XB; g.Bt = (const bf16_t*)(ws + OFF_WOUT + l * SZ_WOUT); g.M = NTOK; g.N = DM; g.K = DM; E.mode = 1; }
                pg8::StaticOrder S; S.init(g.M, g.N, (int)gridDim.x, (int)blockIdx.x);
                pg8::gemm_phase<EpiAll, pg8::StaticOrder, PG8_ALIGN, PG8_SP2>(lds, g, S, E);
#endif
            } else if (st == 2 || st == 10 || st == 13) {
                const int kind = st == 2 ? 0 : (st == 10 ? 1 : 2);
#ifndef NO_LN
                ln_phase(X, X, XB, p.ln_g + (size_t)(l * 3 + kind) * DM, p.ln_b + (size_t)(l * 3 + kind) * DM, kind == 0 || (l == 1 && kind == 2), !(l == 1 && kind == 2), gw, ngw, lane);
#endif
            } else if (st == 5) {
                if (l == 0) {
#ifndef NO_MIX0
                    conv_phase(HU, p.convw, XB, gtid, nthr);
                    xattn_phase(lds, HU, LDU0, 2304, MEMKV, XB, tid);
#endif
                } else {
#ifndef NO_M0
                    m0_phase(GATES, p.bgates, GB, GLI, GM, gw, ngw, lane);
                    xattn_phase(lds, HU, LDU1, 3072, MEMKV, XB, tid);
#endif
                }
            } else if (st == 6) {
#ifndef NO_M1
                m1_phase(lds, HU, p.qkconvw, GB, GLI, GM, GM, CBUF, NBUF, tid);
#endif
            } else if (st == 7) {
#ifndef NO_M2
                m2_phase(CBUF, NBUF, GM, tid);
#endif
            } else {
#ifndef NO_M3
                m3_phase(lds, HU, p.qkconvw, p.hng, GB, GLI, GM, CBUF, NBUF, XB, tid);
#endif
            }
            if (st != 3 && !(l == 1 && st == 13)) GRID_SYNC();
        }
    }
}

#undef GRID_SYNC
#undef tid
#undef wave
#undef lane
#undef gw
#undef ngw
#undef gtid
#undef nthr
extern "C" void kernel_launch(void* const* d_in, const int* in_sizes, int n_in, void* d_out, int out_size, void* d_ws, size_t ws_size, hipStream_t stream) {
    static int grid_blocks = 0;
    if (grid_blocks == 0) {
        if (n_in != 15 || ws_size < WS_END) { fprintf(stderr, "kernel_launch: unexpected n_in %d or workspace %zu < %zu\n", n_in, ws_size, (size_t)WS_END); grid_blocks = -1; return; }
        int dev = 0, cus = 0, per_cu = 0;
        hipGetDevice(&dev);
        hipDeviceGetAttribute(&cus, hipDeviceAttributeMultiprocessorCount, dev);
        if (hipFuncSetAttribute((const void*)fwd_kernel, hipFuncAttributeMaxDynamicSharedMemorySize, LDS_BYTES) != hipSuccess) fprintf(stderr, "kernel_launch: hipFuncSetAttribute failed\n");
        if (hipOccupancyMaxActiveBlocksPerMultiprocessor(&per_cu, (const void*)fwd_kernel, 512, LDS_BYTES) != hipSuccess || per_cu < 1) { per_cu = 1; (void)hipGetLastError(); }
        grid_blocks = cus * 1;
        (void)per_cu;
    }
    if (grid_blocks < 0) return;
    Params p{};
    p.x = (const float*)d_in[0]; p.mem = (const float*)d_in[1]; p.ln_g = (const float*)d_in[2]; p.ln_b = (const float*)d_in[3];
    p.wg = (const float*)d_in[4]; p.wu = (const float*)d_in[5]; p.wd = (const float*)d_in[6]; p.wkv = (const float*)d_in[7]; p.wout = (const float*)d_in[8];
    p.win0 = (const float*)d_in[9]; p.convw = (const float*)d_in[10]; p.win1 = (const float*)d_in[11]; p.bgates = (const float*)d_in[12];
    p.qkconvw = (const float*)d_in[13]; p.hng = (const float*)d_in[14];
    p.out = (float*)d_out; p.ws = (unsigned char*)d_ws;
    if (hipMemsetAsync((unsigned char*)d_ws + OFF_BAR, 0, (size_t)3456 * 4, stream) != hipSuccess) fprintf(stderr, "kernel_launch: hipMemsetAsync failed\n");
    void* args[] = {&p};
    hipError_t e = hipLaunchCooperativeKernel((const void*)fwd_kernel, dim3(grid_blocks), dim3(512), args, LDS_BYTES, stream);
    if (e != hipSuccess) fprintf(stderr, "kernel_launch: cooperative launch failed: %s (grid %d)\n", hipGetErrorString(e), grid_blocks);
}
```

```cpp
#include <hip/hip_runtime.h>
#include <hip/hip_cooperative_groups.h>
#include <cstdio>
#include <cstdint>
namespace cg = cooperative_groups;
namespace pg8 {
#define PG8_LAS __attribute__((address_space(3)))
typedef unsigned short bf16_t;
typedef short bf16x8 __attribute__((ext_vector_type(8)));
typedef float f32x4 __attribute__((ext_vector_type(4)));
typedef unsigned u32x4 __attribute__((ext_vector_type(4)));
constexpr int BM = 256, BK = 64, HALF = 128, HTB = HALF * BK * 2  , STAGE_BYTES = 8 * HTB, NXCD = 8, WGM = 8;

__host__ __device__ __forceinline__ int lds_byte(int r, int c) { const int st = (r >> 4) * 2 + (c >> 5), rr = r & 15, cc = c & 31, ob = rr * 64 + cc * 2; return st * 1024 + (ob ^ (((ob >> 9) & 1) << 5)); }
__host__ __device__ __forceinline__ void stage_rc(int b, int& R, int& C) { const int st = b / 1024, sb = b % 1024, swz = sb ^ (((sb >> 9) & 1) << 5); R = (st >> 1) * 16 + swz / 64; C = (st & 1) * 32 + (swz % 64) / 2; }
__host__ __device__ __forceinline__ int perm32(int rho) { const int n = rho >> 4, i = rho & 15; return 8 * (i >> 2) + 4 * n + (i & 3); }

struct Unit { int pm, pn; };
struct Gemm { const bf16_t* A; const bf16_t* Bt; int M, N, K; };

struct StaticOrder {
    int nM, nN, nwg, G, c;
    __host__ __device__ void init(int M, int N, int G_, int c_) { nM = M / BM; nN = N / BM; nwg = nM * nN; G = G_; c = c_; }
    __host__ __device__ bool next(int i, Unit& u) const {
        const long L = (long)i * G + c; if (L >= nwg) return false;
        int wgid = (int)L; { const int q = nwg / NXCD, r = nwg % NXCD, xcd = wgid % NXCD, off = wgid / NXCD; wgid = (xcd < r ? xcd * (q + 1) : r * (q + 1) + (xcd - r) * q) + off; }
        const int nig = WGM * nN, gid = wgid / nig, fm = gid * WGM, gsz = (nM - fm) < WGM ? (nM - fm) : WGM;
        u.pm = fm + ((wgid % nig) % gsz); u.pn = (wgid % nig) / gsz; return true;
    }
    __device__ __forceinline__ void a_ready(const Unit&) const {}
    __device__ __forceinline__ void done(const Unit&) const {}
};
__device__ __forceinline__ unsigned cvt_pk_bf16(float lo, float hi) { unsigned r; asm volatile("v_cvt_pk_bf16_f32 %0, %1, %2" : "=v"(r) : "v"(lo), "v"(hi)); return r; }
typedef float f32x2 __attribute__((ext_vector_type(2)));
template <class Epi, class Sched, bool ALIGN_EPI = false, bool SP2 = false>
__device__ __forceinline__ void gemm_phase(PG8_LAS unsigned char* lds, const Gemm g, const Sched& S, const Epi& E) {
    int tid_ = threadIdx.x; asm volatile("" : "+v"(tid_));
    const int tid = tid_, wid = __builtin_amdgcn_readfirstlane(tid >> 6), lane = tid & 63, wr = wid >> 2, wc = wid & 3, fr = lane & 15, fq = lane >> 4;
    const int K = g.K, nt = K / BK;
    unsigned voffA[2], voffB[2];
#pragma unroll
    for (int i = 0; i < 2; ++i) { int R, C; stage_rc(tid * 16 + i * 8192, R, C); const int Rb = Epi::PERM ? ((R & ~31) + perm32(R & 31)) : R;
        voffA[i] = (unsigned)(R * K + C) * 2u; voffB[i] = (unsigned)(Rb * K + C) * 2u; }
    const size_t kstep = (size_t)(BK * 2);
    const size_t hstep = (size_t)HALF * K * 2;
    const size_t tstep = 2 * hstep;
    const unsigned ldsw = (unsigned)wid * 1024u;
    const int aoff = lds_byte(wr * 64 + fr, fq * 8), boff = lds_byte(wc * 32 + fr, fq * 8);
#define PG8_SA(b, h) (((b) * 2 + (h)) * HTB)
#define PG8_SB(b, h) ((4 + (b) * 2 + (h)) * HTB)
#define PG8_STAGE(bufoff, gbase, voff) do { _Pragma("unroll") for (int _i = 0; _i < 2; ++_i) \
        __builtin_amdgcn_global_load_lds((const unsigned*)((const char*)(gbase) + (voff)[_i]), (PG8_LAS unsigned*)(lds + (bufoff) + ldsw + _i * 8192), 16, 0, 0); } while (0)
#define PG8_LDA(dst, b, h) do { _Pragma("unroll") for (int m = 0; m < 4; ++m) _Pragma("unroll") for (int k = 0; k < 2; ++k) dst[m][k] = *(const PG8_LAS bf16x8*)(lds + PG8_SA(b, h) + aoff + m * 2048 + k * 1024); } while (0)
#define PG8_LDB(dst, b, h) do { _Pragma("unroll") for (int n = 0; n < 2; ++n) _Pragma("unroll") for (int k = 0; k < 2; ++k) dst[n][k] = *(const PG8_LAS bf16x8*)(lds + PG8_SB(b, h) + boff + n * 2048 + k * 1024); } while (0)
#define PG8_MMA(ai, bj, At, Bt) do { __builtin_amdgcn_s_setprio(1); _Pragma("unroll") for (int m = 0; m < 4; ++m) _Pragma("unroll") for (int n = 0; n < 2; ++n) _Pragma("unroll") for (int k = 0; k < 2; ++k) \
        acc[ai][bj][m][n] = __builtin_amdgcn_mfma_f32_16x16x32_bf16(Bt[n][k], At[m][k], acc[ai][bj][m][n], 0, 0, 0); __builtin_amdgcn_s_setprio(0); } while (0)
#define PG8_WAIT_V(n) asm volatile("s_waitcnt vmcnt(" #n ")" ::: "memory")
#define PG8_WAIT_L(n) asm volatile("s_waitcnt lgkmcnt(" #n ")" ::: "memory")
#define PG8_BAR __builtin_amdgcn_s_barrier()
#define PG8_SCHED __builtin_amdgcn_sched_barrier(0)
    Unit cur, nxt; int ui = 0;
    if (!S.next(0, cur)) return;
    f32x4 acc[2][2][4][2];
#pragma unroll
    for (int a = 0; a < 2; ++a)
#pragma unroll
        for (int b = 0; b < 2; ++b)
#pragma unroll
            for (int m = 0; m < 4; ++m)
#pragma unroll
                for (int n = 0; n < 2; ++n) acc[a][b][m][n] = (f32x4){0.f, 0.f, 0.f, 0.f};
    bf16x8 At[4][2], B0[2][2], B1[2][2];
    const char* cA = (const char*)g.A + (size_t)cur.pm * tstep; const char* cB = (const char*)g.Bt + (size_t)cur.pn * tstep;
    S.a_ready(cur);
    if constexpr (SP2) {
        PG8_STAGE(PG8_SB(0, 0), cB, voffB); PG8_STAGE(PG8_SB(0, 1), cB + hstep, voffB); PG8_STAGE(PG8_SA(0, 0), cA, voffA); PG8_STAGE(PG8_SA(0, 1), cA + hstep, voffA);
        if (wr == 1) PG8_BAR;
        PG8_WAIT_V(2); PG8_BAR;
        PG8_STAGE(PG8_SB(1, 0), cB + kstep, voffB); PG8_STAGE(PG8_SA(1, 0), cA + kstep, voffA); PG8_STAGE(PG8_SB(1, 1), cB + hstep + kstep, voffB);
        PG8_WAIT_V(6); PG8_BAR;
    } else {
        PG8_STAGE(PG8_SB(0, 0), cB, voffB); PG8_STAGE(PG8_SA(0, 0), cA, voffA); PG8_STAGE(PG8_SB(0, 1), cB + hstep, voffB); PG8_STAGE(PG8_SA(0, 1), cA + hstep, voffA);
        if (wr == 1) PG8_BAR;
        PG8_WAIT_V(4); PG8_BAR;
        PG8_STAGE(PG8_SB(1, 0), cB + kstep, voffB); PG8_STAGE(PG8_SA(1, 0), cA + kstep, voffA); PG8_STAGE(PG8_SB(1, 1), cB + hstep + kstep, voffB);
        PG8_WAIT_V(6); PG8_BAR;
    }
    for (;;) {
        const bool has_next = S.next(ui + 1, nxt);
        const char* nA = has_next ? (const char*)g.A + (size_t)nxt.pm * tstep : cA; const char* nB = has_next ? (const char*)g.Bt + (size_t)nxt.pn * tstep : cB;
        for (int t = 0; t < nt; t += 2) {
            const bool last = (t == nt - 2);
            const char* a1 = cA + (size_t)(t + 1) * kstep;
            const char* a2 = last ? nA : cA + (size_t)(t + 2) * kstep; const char* b2 = last ? nB : cB + (size_t)(t + 2) * kstep;
            const char* a3 = a2 + kstep; const char* b3 = b2 + kstep;
            if (last && has_next) S.a_ready(nxt);
            if constexpr (SP2) {
            PG8_LDB(B0, 0, 0); PG8_LDB(B1, 0, 1); PG8_SCHED; PG8_LDA(At, 0, 0); PG8_STAGE(PG8_SA(1, 1), a1 + hstep, voffA);
            PG8_WAIT_V(8); PG8_WAIT_L(0); PG8_BAR; PG8_MMA(0, 0, At, B0); PG8_MMA(0, 1, At, B1); PG8_BAR; PG8_SCHED;
            PG8_LDA(At, 0, 1); PG8_STAGE(PG8_SB(0, 0), b2, voffB); PG8_STAGE(PG8_SB(0, 1), b2 + hstep, voffB); PG8_STAGE(PG8_SA(0, 0), a2, voffA);
            PG8_WAIT_V(8); PG8_WAIT_L(0); PG8_BAR; PG8_MMA(1, 0, At, B0); PG8_MMA(1, 1, At, B1); PG8_BAR; PG8_SCHED;
            PG8_LDB(B0, 1, 0); PG8_LDB(B1, 1, 1); PG8_SCHED; PG8_LDA(At, 1, 0); PG8_STAGE(PG8_SA(0, 1), a2 + hstep, voffA);
            PG8_WAIT_V(8); PG8_WAIT_L(0); PG8_BAR; PG8_MMA(0, 0, At, B0); PG8_MMA(0, 1, At, B1); PG8_BAR; PG8_SCHED;
            PG8_LDA(At, 1, 1); PG8_STAGE(PG8_SB(1, 0), b3, voffB); PG8_STAGE(PG8_SB(1, 1), b3 + hstep, voffB); PG8_STAGE(PG8_SA(1, 0), a3, voffA);
            PG8_WAIT_V(8); PG8_WAIT_L(0); PG8_BAR; PG8_MMA(1, 0, At, B0); PG8_MMA(1, 1, At, B1); PG8_BAR; PG8_SCHED;
            } else {
            PG8_LDB(B0, 0, 0); PG8_SCHED; PG8_LDA(At, 0, 0); PG8_STAGE(PG8_SA(1, 1), a1 + hstep, voffA);
            PG8_WAIT_L(8); PG8_BAR; PG8_WAIT_L(0); PG8_MMA(0, 0, At, B0); PG8_BAR; PG8_SCHED;
            PG8_LDB(B1, 0, 1); PG8_STAGE(PG8_SB(0, 0), b2, voffB);
            PG8_BAR; PG8_WAIT_L(0); PG8_MMA(0, 1, At, B1); PG8_BAR;
            PG8_LDA(At, 0, 1); PG8_STAGE(PG8_SA(0, 0), a2, voffA);
            PG8_BAR; PG8_WAIT_L(0); PG8_MMA(1, 0, At, B0); PG8_BAR; PG8_SCHED;
            PG8_STAGE(PG8_SB(0, 1), b2 + hstep, voffB);
            PG8_WAIT_V(6); PG8_BAR; PG8_MMA(1, 1, At, B1); PG8_BAR;
            PG8_LDB(B0, 1, 0); PG8_SCHED; PG8_LDA(At, 1, 0); PG8_STAGE(PG8_SA(0, 1), a2 + hstep, voffA);
            PG8_WAIT_L(8); PG8_BAR; PG8_WAIT_L(0); PG8_MMA(0, 0, At, B0); PG8_BAR; PG8_SCHED;
            PG8_LDB(B1, 1, 1); PG8_STAGE(PG8_SB(1, 0), b3, voffB);
            PG8_BAR; PG8_WAIT_L(0); PG8_MMA(0, 1, At, B1); PG8_BAR;
            PG8_LDA(At, 1, 1); PG8_STAGE(PG8_SA(1, 0), a3, voffA);
            PG8_BAR; PG8_WAIT_L(0); PG8_MMA(1, 0, At, B0); PG8_BAR; PG8_SCHED;
            PG8_STAGE(PG8_SB(1, 1), b3 + hstep, voffB);
            PG8_WAIT_V(6); PG8_BAR; PG8_MMA(1, 1, At, B1); PG8_BAR;
            }
        }
        if constexpr (ALIGN_EPI) { if (wr == 0) PG8_BAR; }
        if constexpr (!Epi::AFTER_DRAIN) { E(acc, cur, wr, wc, fr, fq); S.done(cur); }
        if (!has_next) break;
#pragma unroll
        for (int a = 0; a < 2; ++a)
#pragma unroll
            for (int b = 0; b < 2; ++b)
#pragma unroll
                for (int m = 0; m < 4; ++m)
#pragma unroll
                    for (int n = 0; n < 2; ++n) acc[a][b][m][n] = (f32x4){0.f, 0.f, 0.f, 0.f};
        cur = nxt; cA = nA; cB = nB; ++ui;
        if constexpr (ALIGN_EPI) { if (wr == 1) PG8_BAR; }
    }
    PG8_WAIT_V(0);
    if constexpr (!ALIGN_EPI) { if (wr == 0) PG8_BAR; }
    PG8_BAR;
    if constexpr (Epi::AFTER_DRAIN) { E.fused(acc, cur, wr, wc, fr, fq, lds, wid, lane); S.done(cur); }
#undef PG8_SA
#undef PG8_SB
#undef PG8_STAGE
#undef PG8_LDA
#undef PG8_LDB
#undef PG8_MMA
#undef PG8_WAIT_V
#undef PG8_WAIT_L
#undef PG8_BAR
#undef PG8_SCHED
}
}

using pg8::bf16_t; using pg8::bf16x8; using pg8::f32x4; using pg8::u32x4; using pg8::Unit;
#define LAS __attribute__((address_space(3)))
typedef unsigned u32x2 __attribute__((ext_vector_type(2)));

constexpr int NTOK = 32768, DM = 1024, FF = 2816, SEQ = 4096;
constexpr int LDU0 = 2560, LDU1 = 3328, NIN1P = 3584, NS1 = 3336;
constexpr float LN_EPS = 1e-5f, ALPHA = 1.41421356237f, RS192 = 0.07216878364870322f;
constexpr int LDS_MAIN = 158720, LDS_BYTES = LDS_MAIN + 16;
#ifndef PG8_SP2
#define PG8_SP2 true
#endif
#ifndef PG8_ALIGN
#define PG8_ALIGN true
#endif
#ifndef DUP_ST
#define DUP_ST (-1)
#endif
#ifndef DUP_L
#define DUP_L (-1)
#endif
#ifndef EXTRA_SYNC
#define EXTRA_SYNC 0
#endif
#ifndef DUP_PRO
#define DUP_PRO 0
#endif
#ifndef DUP_LN
#define DUP_LN 0
#endif

constexpr size_t SZ_WGU = (size_t)5632 * 1024 * 2, SZ_WD = (size_t)1024 * 2816 * 2, SZ_WKV = (size_t)512 * 1024 * 2, SZ_WOUT = (size_t)1024 * 1024 * 2;
constexpr size_t OFF_WGU = 0;
constexpr size_t OFF_WD = OFF_WGU + 4 * SZ_WGU;
constexpr size_t OFF_WKV = OFF_WD + 4 * SZ_WD;
constexpr size_t OFF_WOUT = OFF_WKV + 2 * SZ_WKV;
constexpr size_t OFF_WIN0 = OFF_WOUT + 2 * SZ_WOUT;
constexpr size_t OFF_WIN1 = OFF_WIN0 + (size_t)2560 * 1024 * 2;
constexpr size_t OFF_XB = OFF_WIN1 + (size_t)NIN1P * 1024 * 2;
constexpr size_t OFF_HU = OFF_XB + (size_t)NTOK * 1024 * 2;
constexpr size_t OFF_CBUF = OFF_HU + (size_t)NTOK * LDU1 * 2;
constexpr size_t OFF_MEMB = OFF_CBUF + (size_t)2048 * 36864 * 2;
constexpr size_t OFF_MEMKV = OFF_MEMB + (size_t)2048 * 1024 * 2;
constexpr size_t OFF_GATES = OFF_MEMKV + (size_t)2 * 2048 * 512 * 2;
constexpr size_t OFF_NBUF = OFF_GATES + (size_t)NTOK * 8 * 4;
constexpr size_t OFF_GB = OFF_NBUF + (size_t)2048 * 192 * 4;
constexpr size_t OFF_GLI = OFF_GB + (size_t)32 * 4096 * 4;
constexpr size_t OFF_GM = OFF_GLI + (size_t)32 * 4096 * 4;
constexpr size_t OFF_BAR = OFF_GM + (size_t)5 * 2048 * 4;
constexpr size_t WS_END = OFF_BAR + (size_t)3456 * 4;

struct Params {
    const float *x, *mem, *ln_g, *ln_b, *wg, *wu, *wd, *wkv, *wout, *win0, *convw, *win1, *bgates, *qkconvw, *hng;
    float* out; unsigned char* ws;
};

__device__ __forceinline__ float bf2f(unsigned b) { return __uint_as_float(b << 16); }
__device__ __forceinline__ unsigned f2bf(float f) { unsigned u = __float_as_uint(f); u += 0x7FFFu + ((u >> 16) & 1u); return u >> 16; }
__device__ __forceinline__ unsigned pk2(float lo, float hi) { return f2bf(lo) | (f2bf(hi) << 16); }
__device__ __forceinline__ float silu_f(float v) { return v * __builtin_amdgcn_rcpf(1.0f + __expf(-v)); }
__device__ __forceinline__ float sigmoid_f(float v) { return __builtin_amdgcn_rcpf(1.0f + __expf(-v)); }
__device__ __forceinline__ float wsum(float v) {
#pragma unroll
    for (int o = 1; o < 64; o <<= 1) v += __shfl_xor(v, o);
    return v;
}
__device__ __forceinline__ float wmax(float v) {
#pragma unroll
    for (int o = 1; o < 64; o <<= 1) v = fmaxf(v, __shfl_xor(v, o));
    return v;
}
#define LO16(w) bf2f((w) & 0xffffu)
#define HI16(w) __uint_as_float((w) & 0xffff0000u)
#define MFMA16(a, b, c) __builtin_amdgcn_mfma_f32_16x16x32_bf16((a), (b), (c), 0, 0, 0)

struct EpiSwiglu {
    static constexpr bool PERM = true, AFTER_DRAIN = false;
    bf16_t* H;
    __device__ __forceinline__ void operator()(const f32x4 (&acc)[2][2][4][2], const Unit& u, int wr, int wc, int fr, int fq) const {
        const int row0 = u.pm * 256 + wr * 64 + fr, col0 = u.pn * 128 + wc * 32 + 8 * fq;
#pragma unroll
        for (int ai = 0; ai < 2; ++ai)
#pragma unroll
            for (int m = 0; m < 4; ++m) {
                bf16_t* rowp = H + (size_t)(row0 + ai * 128 + m * 16) * FF + col0;
                const f32x4 g0 = acc[ai][0][m][0], g1 = acc[ai][0][m][1], u0 = acc[ai][1][m][0], u1 = acc[ai][1][m][1];
                u32x4 w;
                w.x = pg8::cvt_pk_bf16(silu_f(g0[0]) * u0[0], silu_f(g0[1]) * u0[1]);
                w.y = pg8::cvt_pk_bf16(silu_f(g0[2]) * u0[2], silu_f(g0[3]) * u0[3]);
                w.z = pg8::cvt_pk_bf16(silu_f(g1[0]) * u1[0], silu_f(g1[1]) * u1[1]);
                w.w = pg8::cvt_pk_bf16(silu_f(g1[2]) * u1[2], silu_f(g1[3]) * u1[3]);
                *(u32x4*)rowp = w;
            }
    }
};
struct EpiRes {
    static constexpr bool PERM = false, AFTER_DRAIN = false;
    const float* res; float* out; float scale;
    __device__ __forceinline__ void operator()(const f32x4 (&acc)[2][2][4][2], const Unit& u, int wr, int wc, int fr, int fq) const {
        const int row0 = u.pm * 256 + wr * 64 + fr, col0 = u.pn * 256 + wc * 32 + 4 * fq;
#pragma unroll
        for (int ai = 0; ai < 2; ++ai)
#pragma unroll
            for (int m = 0; m < 4; ++m) {
                const size_t off = (size_t)(row0 + ai * 128 + m * 16) * DM + col0;
#pragma unroll
                for (int bj = 0; bj < 2; ++bj)
#pragma unroll
                    for (int n = 0; n < 2; ++n) {
                        const f32x4 r = *(const f32x4*)(res + off + bj * 128 + n * 16);
                        *(f32x4*)(out + off + bj * 128 + n * 16) = r * ALPHA + acc[ai][bj][m][n] * scale;
                    }
                asm volatile("" ::: "memory");
            }
    }
};
struct EpiU {
    static constexpr bool PERM = true, AFTER_DRAIN = false;
    bf16_t* O; int ldc; int nstore; float* gates; int gate_pn;
    __device__ __forceinline__ void operator()(const f32x4 (&acc)[2][2][4][2], const Unit& u, int wr, int wc, int fr, int fq) const {
        const int row0 = u.pm * 256 + wr * 64 + fr;
        if (u.pn < nstore) {
            const int col0 = u.pn * 256 + wc * 32 + 8 * fq;
#pragma unroll
            for (int ai = 0; ai < 2; ++ai)
#pragma unroll
                for (int m = 0; m < 4; ++m) {
                    bf16_t* rowp = O + (size_t)(row0 + ai * 128 + m * 16) * ldc + col0;
#pragma unroll
                    for (int bj = 0; bj < 2; ++bj) {
                        const f32x4 v0 = acc[ai][bj][m][0], v1 = acc[ai][bj][m][1];
                        u32x4 w; w.x = pg8::cvt_pk_bf16(v0[0], v0[1]); w.y = pg8::cvt_pk_bf16(v0[2], v0[3]); w.z = pg8::cvt_pk_bf16(v1[0], v1[1]); w.w = pg8::cvt_pk_bf16(v1[2], v1[3]);
                        *(u32x4*)(rowp + bj * 128) = w;
                    }
                }
        } else if (u.pn == gate_pn) {
            if (wc == 0 && fq == 0) {
#pragma unroll
                for (int ai = 0; ai < 2; ++ai)
#pragma unroll
                    for (int m = 0; m < 4; ++m) {
                        float* gp = gates + (size_t)(row0 + ai * 128 + m * 16) * 8;
                        *(f32x4*)gp = acc[ai][0][m][0]; *(f32x4*)(gp + 4) = acc[ai][0][m][1];
                    }
            }
        }
    }
};

struct EpiAll {
    static constexpr bool PERM = true, AFTER_DRAIN = false;
    int mode; bf16_t* O; int ldc; int nstore; float* gates; int gate_pn; const float* res; const bf16_t* resb; float* out; float scale;
    __device__ __forceinline__ void operator()(const f32x4 (&acc)[2][2][4][2], const Unit& u, int wr, int wc, int fr, int fq) const {
        const int row0 = u.pm * 256 + wr * 64 + fr;
        if (mode == 0) {
            const int col0 = u.pn * 128 + wc * 32 + 8 * fq;
#pragma unroll
            for (int ai = 0; ai < 2; ++ai)
#pragma unroll
                for (int m = 0; m < 4; ++m) {
                    bf16_t* rowp = O + (size_t)(row0 + ai * 128 + m * 16) * FF + col0;
                    const f32x4 g0 = acc[ai][0][m][0], g1 = acc[ai][0][m][1], u0 = acc[ai][1][m][0], u1 = acc[ai][1][m][1];
                    u32x4 w;
                    w.x = pg8::cvt_pk_bf16(silu_f(g0[0]) * u0[0], silu_f(g0[1]) * u0[1]);
                    w.y = pg8::cvt_pk_bf16(silu_f(g0[2]) * u0[2], silu_f(g0[3]) * u0[3]);
                    w.z = pg8::cvt_pk_bf16(silu_f(g1[0]) * u1[0], silu_f(g1[1]) * u1[1]);
                    w.w = pg8::cvt_pk_bf16(silu_f(g1[2]) * u1[2], silu_f(g1[3]) * u1[3]);
                    *(u32x4*)rowp = w;
                }
        } else if (mode == 1) {
            const int col0 = u.pn * 256 + wc * 32 + 8 * fq;
#pragma unroll
            for (int ai = 0; ai < 2; ++ai)
#pragma unroll
                for (int m = 0; m < 4; ++m) {
                    const size_t off = (size_t)(row0 + ai * 128 + m * 16) * DM + col0;
#pragma unroll
                    for (int bj = 0; bj < 2; ++bj) {
                        f32x4 r0, r1;
                        if (resb) { const u32x4 rb = *(const u32x4*)(resb + off + bj * 128); r0 = (f32x4){LO16(rb.x), HI16(rb.x), LO16(rb.y), HI16(rb.y)}; r1 = (f32x4){LO16(rb.z), HI16(rb.z), LO16(rb.w), HI16(rb.w)}; }
                        else { r0 = *(const f32x4*)(res + off + bj * 128); r1 = *(const f32x4*)(res + off + bj * 128 + 4); }
                        *(f32x4*)(out + off + bj * 128) = r0 * ALPHA + acc[ai][bj][m][0] * scale;
                        *(f32x4*)(out + off + bj * 128 + 4) = r1 * ALPHA + acc[ai][bj][m][1] * scale;
                    }
                    if (m == 3 && !resb) asm volatile("" ::: "memory");
                }
        } else {
            if (u.pn < nstore) {
                const int col0 = u.pn * 256 + wc * 32 + 8 * fq;
#pragma unroll
                for (int ai = 0; ai < 2; ++ai)
#pragma unroll
                    for (int m = 0; m < 4; ++m) {
                        bf16_t* rowp = O + (size_t)(row0 + ai * 128 + m * 16) * ldc + col0;
#pragma unroll
                        for (int bj = 0; bj < 2; ++bj) {
                            const f32x4 v0 = acc[ai][bj][m][0], v1 = acc[ai][bj][m][1];
                            u32x4 w; w.x = pg8::cvt_pk_bf16(v0[0], v0[1]); w.y = pg8::cvt_pk_bf16(v0[2], v0[3]); w.z = pg8::cvt_pk_bf16(v1[0], v1[1]); w.w = pg8::cvt_pk_bf16(v1[2], v1[3]);
                            *(u32x4*)(rowp + bj * 128) = w;
                        }
                    }
            } else if (u.pn == gate_pn) {
                if (wc == 0 && fq == 0) {
#pragma unroll
                    for (int ai = 0; ai < 2; ++ai)
#pragma unroll
                        for (int m = 0; m < 4; ++m) {
                            float* gp = gates + (size_t)(row0 + ai * 128 + m * 16) * 8;
                            *(f32x4*)gp = acc[ai][0][m][0]; *(f32x4*)(gp + 4) = acc[ai][0][m][1];
                        }
                }
            }
        }
    }
};

__device__ __forceinline__ void tr_item(const float* colp4, int Ns, bf16_t* WT, int K, int r0, int k0, LAS float* scr, int lane) {
    f32x4 v[8];
#pragma unroll
    for (int i = 0; i < 8; ++i) { const int kk = (lane >> 3) + 8 * i; v[i] = colp4 ? *(const f32x4*)(colp4 + (size_t)(k0 + kk) * Ns) : (f32x4){0.f, 0.f, 0.f, 0.f}; }
#pragma unroll
    for (int i = 0; i < 8; ++i) { const int kk = (lane >> 3) + 8 * i; LAS float* d = scr + kk * 33 + 4 * (lane & 7); d[0] = v[i][0]; d[1] = v[i][1]; d[2] = v[i][2]; d[3] = v[i][3]; }
    asm volatile("s_waitcnt lgkmcnt(0)" ::: "memory");
    const int c = lane & 7;
#pragma unroll
    for (int j = 0; j < 4; ++j) { const int n = (lane >> 3) + 8 * j; const LAS float* s = scr + (8 * c) * 33 + n;
        u32x4 o; o.x = pk2(s[0], s[33]); o.y = pk2(s[2 * 33], s[3 * 33]); o.z = pk2(s[4 * 33], s[5 * 33]); o.w = pk2(s[6 * 33], s[7 * 33]);
        *(u32x4*)(WT + (size_t)(r0 + n) * K + k0 + 8 * c) = o; }
    asm volatile("s_waitcnt lgkmcnt(0)" ::: "memory");
}
__device__ __forceinline__ void cvt_rows(const float* src, bf16_t* dst, size_t n8, size_t gtid, size_t nthr) {
    for (size_t i = gtid; i < n8; i += nthr) { const f32x4 a = *(const f32x4*)(src + i * 8), b = *(const f32x4*)(src + i * 8 + 4);
        u32x4 w; w.x = pk2(a[0], a[1]); w.y = pk2(a[2], a[3]); w.z = pk2(b[0], b[1]); w.w = pk2(b[2], b[3]); *(u32x4*)(dst + i * 8) = w; }
}
__device__ __forceinline__ void prologue(const Params& p, LAS unsigned char* lds, int gw, int ngw, int wave, int lane, size_t gtid, size_t nthr) {
    LAS float* scr = (LAS float*)(lds + wave * 8704);
    unsigned char* ws = p.ws;
    constexpr int I_GU = 176 * 16, I_D = 32 * 44, I_KV = 16 * 16, I_O = 32 * 16, I_0 = 80 * 16, I_1 = 112 * 16;
    constexpr int NITEMS = 4 * I_GU + 4 * I_D + 2 * I_KV + 2 * I_O + I_0 + I_1;
    const int l31 = 4 * (lane & 7);
    for (int it = gw; it < NITEMS; it += ngw) {
        int r = it;
        if (r < 4 * I_GU) { const int m = r / I_GU; r -= m * I_GU; const int kb = r / 176, nb = r % 176, row = nb * 32 + l31, pn = row >> 8, bj = (row >> 7) & 1, j = row & 127;
            tr_item((bj ? p.wu : p.wg) + (size_t)m * 1024 * FF + 128 * pn + j, FF, (bf16_t*)(ws + OFF_WGU + m * SZ_WGU), 1024, nb * 32, kb * 64, scr, lane); continue; }
        r -= 4 * I_GU;
        if (r < 4 * I_D) { const int m = r / I_D; r -= m * I_D; const int kb = r >> 5, nb = r & 31, row = nb * 32 + l31;
            tr_item(p.wd + (size_t)m * FF * 1024 + row, 1024, (bf16_t*)(ws + OFF_WD + m * SZ_WD), FF, nb * 32, kb * 64, scr, lane); continue; }
        r -= 4 * I_D;
        if (r < 2 * I_KV) { const int m = r / I_KV; r -= m * I_KV; const int kb = r >> 4, nb = r & 15, row = nb * 32 + l31;
            tr_item(p.wkv + (size_t)m * 1024 * 512 + row, 512, (bf16_t*)(ws + OFF_WKV + m * SZ_WKV), 1024, nb * 32, kb * 64, scr, lane); continue; }
        r -= 2 * I_KV;
        if (r < 2 * I_O) { const int m = r / I_O; r -= m * I_O; const int kb = r >> 5, nb = r & 31, row = nb * 32 + l31;
            tr_item(p.wout + (size_t)m * 1024 * 1024 + row, 1024, (bf16_t*)(ws + OFF_WOUT + m * SZ_WOUT), 1024, nb * 32, kb * 64, scr, lane); continue; }
        r -= 2 * I_O;
        if (r < I_0) { const int kb = r / 80, nb = r % 80, row = nb * 32 + l31;
            tr_item(p.win0 + row, LDU0, (bf16_t*)(ws + OFF_WIN0), 1024, nb * 32, kb * 64, scr, lane); continue; }
        r -= I_0;
        { const int kb = r / 112, nb = r % 112, row = nb * 32 + l31;
          const int col = row < 3072 ? row : (row < 3328 ? row + 8 : (row < 3336 ? row - 256 : -1));
          tr_item(col >= 0 ? p.win1 + col : (const float*)nullptr, NS1, (bf16_t*)(ws + OFF_WIN1), 1024, nb * 32, kb * 64, scr, lane); }
    }
    cvt_rows(p.x, (bf16_t*)(ws + OFF_XB), (size_t)NTOK * DM / 8, gtid, nthr);
    cvt_rows(p.mem, (bf16_t*)(ws + OFF_MEMB), (size_t)2048 * DM / 8, gtid, nthr);
}

__device__ __forceinline__ void ln_phase(const float* Xin, float* Xout, bf16_t* XB, const float* g, const float* b, bool wf32, bool wbf, int gw, int ngw, int lane) {
    f32x4 gv[4], bv[4];
#pragma unroll
    for (int j = 0; j < 4; ++j) { gv[j] = ((const f32x4*)g)[lane + 64 * j]; bv[j] = ((const f32x4*)b)[lane + 64 * j]; }
    for (int row0 = gw * 4; row0 < NTOK; row0 += ngw * 4) {
        f32x4 v[4][4]; float s[4], s2[4];
#pragma unroll
        for (int r = 0; r < 4; ++r) { const f32x4* xr = (const f32x4*)(Xin + (size_t)(row0 + r) * DM) + lane;
#pragma unroll
            for (int j = 0; j < 4; ++j) v[r][j] = xr[64 * j]; }
#pragma unroll
        for (int r = 0; r < 4; ++r) { s[r] = 0.f;
#pragma unroll
            for (int j = 0; j < 4; ++j) s[r] += (v[r][j][0] + v[r][j][1]) + (v[r][j][2] + v[r][j][3]); }
#pragma unroll
        for (int o = 1; o < 64; o <<= 1)
#pragma unroll
            for (int r = 0; r < 4; ++r) s[r] += __shfl_xor(s[r], o);
#pragma unroll
        for (int r = 0; r < 4; ++r) { const float mean = s[r] * (1.f / DM); s2[r] = 0.f;
#pragma unroll
            for (int j = 0; j < 4; ++j) { v[r][j] = v[r][j] - mean; s2[r] += (v[r][j][0] * v[r][j][0] + v[r][j][1] * v[r][j][1]) + (v[r][j][2] * v[r][j][2] + v[r][j][3] * v[r][j][3]); } }
#pragma unroll
        for (int o = 1; o < 64; o <<= 1)
#pragma unroll
            for (int r = 0; r < 4; ++r) s2[r] += __shfl_xor(s2[r], o);
#pragma unroll
        for (int r = 0; r < 4; ++r) {
            const float rstd = 1.0f / sqrtf(s2[r] * (1.f / DM) + LN_EPS);
            f32x4* xo = (f32x4*)(Xout + (size_t)(row0 + r) * DM) + lane;
            u32x2* bo = (u32x2*)(XB + (size_t)(row0 + r) * DM) + lane;
#pragma unroll
            for (int j = 0; j < 4; ++j) { const f32x4 y = v[r][j] * rstd * gv[j] + bv[j]; if (wf32) xo[64 * j] = y; if (wbf) { u32x2 w; w.x = pk2(y[0], y[1]); w.y = pk2(y[2], y[3]); bo[64 * j] = w; } }
        }
    }
}

__device__ __forceinline__ void conv_phase(const bf16_t* U, const float* cw, bf16_t* MIX, size_t gtid, size_t nthr) {
    for (size_t i = gtid; i < (size_t)NTOK * 96; i += nthr) {
        const int tok = (int)(i / 96), cgi = (int)(i % 96), pos = tok & (SEQ - 1);
        const bf16_t* up = U + (size_t)tok * LDU0 + cgi * 8;
        const u32x4 bg = *(const u32x4*)up;
        float acc[8];
#pragma unroll
        for (int e = 0; e < 8; ++e) acc[e] = 0.f;
#pragma unroll
        for (int j = 0; j < 3; ++j) {
            if (pos - j >= 0) {
                const u32x4 c = *(const u32x4*)(up - (size_t)j * LDU0 + 768), xi = *(const u32x4*)(up - (size_t)j * LDU0 + 1536);
                const f32x4 w0 = *(const f32x4*)(cw + (2 - j) * 768 + cgi * 8), w1 = *(const f32x4*)(cw + (2 - j) * 768 + cgi * 8 + 4);
                acc[0] += w0[0] * LO16(c.x) * LO16(xi.x); acc[1] += w0[1] * HI16(c.x) * HI16(xi.x);
                acc[2] += w0[2] * LO16(c.y) * LO16(xi.y); acc[3] += w0[3] * HI16(c.y) * HI16(xi.y);
                acc[4] += w1[0] * LO16(c.z) * LO16(xi.z); acc[5] += w1[1] * HI16(c.z) * HI16(xi.z);
                acc[6] += w1[2] * LO16(c.w) * LO16(xi.w); acc[7] += w1[3] * HI16(c.w) * HI16(xi.w);
            }
        }
        u32x4 o;
        o.x = pk2(LO16(bg.x) * acc[0], HI16(bg.x) * acc[1]); o.y = pk2(LO16(bg.y) * acc[2], HI16(bg.y) * acc[3]);
        o.z = pk2(LO16(bg.z) * acc[4], HI16(bg.z) * acc[5]); o.w = pk2(LO16(bg.w) * acc[6], HI16(bg.w) * acc[7]);
        *(u32x4*)(MIX + (size_t)tok * DM + cgi * 8) = o;
    }
}

__device__ __forceinline__ void xattn_phase(LAS unsigned char* lds, const bf16_t* U, int ldu, int qoff, const bf16_t* KV, bf16_t* MIX, int tid) {
    const int wave = tid >> 6, lane = tid & 63, fr = lane & 15, fq = lane >> 4;
    LAS bf16_t* Ks = (LAS bf16_t*)lds;
    LAS bf16_t* Vt = Ks + 256 * 72;
    for (int item = blockIdx.x; item < 256; item += gridDim.x) {
        const int b = item >> 5, hd = (item >> 3) & 3, tc = item & 7;
        __syncthreads();
#pragma unroll
        for (int i = 0; i < 4; ++i) {
            const int id = tid + 512 * i, key = id >> 3, dc = id & 7;
            const bf16_t* src = KV + (size_t)(b * 256 + key) * 1024 + hd * 64 + dc * 8;
            const u32x4 kk = *(const u32x4*)src, vv = *(const u32x4*)(src + 256);
            *(LAS u32x4*)(Ks + key * 72 + dc * 8) = kk;
            const int kb = key >> 4, q4 = (key >> 2) & 3, e4 = key & 3, pos = (kb >> 1) * 32 + q4 * 8 + (kb & 1) * 4 + e4;
            LAS bf16_t* vd = Vt + (dc * 8) * 264 + pos;
            vd[0] = (bf16_t)(vv.x & 0xffffu); vd[264] = (bf16_t)(vv.x >> 16); vd[2 * 264] = (bf16_t)(vv.y & 0xffffu); vd[3 * 264] = (bf16_t)(vv.y >> 16);
            vd[4 * 264] = (bf16_t)(vv.z & 0xffffu); vd[5 * 264] = (bf16_t)(vv.z >> 16); vd[6 * 264] = (bf16_t)(vv.w & 0xffffu); vd[7 * 264] = (bf16_t)(vv.w >> 16);
        }
        __syncthreads();
#pragma unroll 1
        for (int tt = 0; tt < 4; ++tt) {
            asm volatile("" ::: "memory");
            const int tok0 = b * SEQ + tc * 512 + (wave * 4 + tt) * 16;
            const bf16_t* qp = U + (size_t)(tok0 + fr) * ldu + qoff + hd * 64 + fq * 8;
            const bf16x8 qf0 = *(const bf16x8*)qp, qf1 = *(const bf16x8*)(qp + 32);
            f32x4 s[16];
#pragma unroll
            for (int kb = 0; kb < 16; ++kb) {
                const LAS bf16_t* kp = Ks + (kb * 16 + fr) * 72 + fq * 8;
                f32x4 a = {0.f, 0.f, 0.f, 0.f};
                a = MFMA16(*(const LAS bf16x8*)kp, qf0, a);
                a = MFMA16(*(const LAS bf16x8*)(kp + 32), qf1, a);
                s[kb] = a;
            }
            float mx = -3.0e38f;
#pragma unroll
            for (int kb = 0; kb < 16; ++kb) mx = fmaxf(mx, fmaxf(fmaxf(s[kb][0], s[kb][1]), fmaxf(s[kb][2], s[kb][3])));
            mx = fmaxf(mx, __shfl_xor(mx, 16)); mx = fmaxf(mx, __shfl_xor(mx, 32));
            const float sc = 0.125f * 1.44269504089f; float sum = 0.f;
#pragma unroll
            for (int kb = 0; kb < 16; ++kb)
#pragma unroll
                for (int j = 0; j < 4; ++j) { const float pe = exp2f((s[kb][j] - mx) * sc); s[kb][j] = pe; sum += pe; }
            sum += __shfl_xor(sum, 16); sum += __shfl_xor(sum, 32);
            const float inv = 1.0f / sum;
            f32x4 o[4];
#pragma unroll
            for (int dn = 0; dn < 4; ++dn) o[dn] = (f32x4){0.f, 0.f, 0.f, 0.f};
#pragma unroll
            for (int ks = 0; ks < 8; ++ks) {
                u32x4 pw; pw.x = pk2(s[2 * ks][0], s[2 * ks][1]); pw.y = pk2(s[2 * ks][2], s[2 * ks][3]); pw.z = pk2(s[2 * ks + 1][0], s[2 * ks + 1][1]); pw.w = pk2(s[2 * ks + 1][2], s[2 * ks + 1][3]);
                const bf16x8 pf = __builtin_bit_cast(bf16x8, pw);
#pragma unroll
                for (int dn = 0; dn < 4; ++dn) o[dn] = MFMA16(*(const LAS bf16x8*)(Vt + (dn * 16 + fr) * 264 + ks * 32 + fq * 8), pf, o[dn]);
            }
            bf16_t* op = MIX + (size_t)(tok0 + fr) * DM + 768 + hd * 64 + fq * 4;
#pragma unroll
            for (int dn = 0; dn < 4; ++dn) { u32x2 w; w.x = pk2(o[dn][0] * inv, o[dn][1] * inv); w.y = pk2(o[dn][2] * inv, o[dn][3] * inv); *(u32x2*)(op + dn * 16) = w; }
        }
    }
}

__device__ __forceinline__ void m0_phase(const float* GATES, const float* bg, float* GB, float* GLI, float* GM, int gw, int ngw, int lane) {
    for (int item = gw; item < 2048; item += ngw) {
        const int bh = item >> 6, c = item & 63, b = bh >> 2, h = bh & 3;
        const size_t tok = (size_t)b * SEQ + c * 64 + lane;
        const float ip = GATES[tok * 8 + h] + bg[h], fp = GATES[tok * 8 + 4 + h] + bg[4 + h];
        const float lf = fminf(fp, 0.f) - log1pf(expf(-fabsf(fp)));
        float bc = lf;
#pragma unroll
        for (int o = 1; o < 64; o <<= 1) { const float t = __shfl_up(bc, o); if (lane >= o) bc += t; }
        const float bl = __shfl(bc, 63);
        const float mxl = wmax(bl - bc + ip);
        GB[(size_t)bh * SEQ + c * 64 + lane] = bc; GLI[(size_t)bh * SEQ + c * 64 + lane] = ip;
        if (lane == 0) { GM[6144 + item] = bl; GM[8192 + item] = mxl; }
    }
}
__device__ __forceinline__ void chunk_stab(const float* GM, int bh, int c, int lane, float& mst_c, float& mnew_c, float& dec_c) {
    const float bl = GM[6144 + bh * 64 + lane], ml = GM[8192 + bh * 64 + lane];
    float B = bl;
#pragma unroll
    for (int o = 1; o < 64; o <<= 1) { const float t = __shfl_up(B, o); if (lane >= o) B += t; }
    float pm = ml - B;
#pragma unroll
    for (int o = 1; o < 64; o <<= 1) { const float t = __shfl_up(pm, o); if (lane >= o) pm = fmaxf(pm, t); }
    const float mnew = B + fmaxf(0.f, pm);
    const float mprev = __shfl_up(mnew, 1);
    const float mst = lane == 0 ? 0.f : mprev;
    const float dec = expf(bl + mst - mnew);
    mst_c = __int_as_float(__builtin_amdgcn_readlane(__float_as_int(mst), c));
    mnew_c = __int_as_float(__builtin_amdgcn_readlane(__float_as_int(mnew), c));
    dec_c = __int_as_float(__builtin_amdgcn_readlane(__float_as_int(dec), c));
}

__device__ __forceinline__ void qk_conv8(const bf16_t* U, const float* qkw, size_t tok, int pos, int col, float (&r)[8]) {
#pragma unroll
    for (int e = 0; e < 8; ++e) r[e] = 0.f;
#pragma unroll
    for (int j = 0; j < 4; ++j) {
        if (pos - j >= 0) {
            const u32x4 v = *(const u32x4*)(U + (tok - j) * LDU1 + col);
            const f32x4 w0 = *(const f32x4*)(qkw + (3 - j) * 1536 + col), w1 = *(const f32x4*)(qkw + (3 - j) * 1536 + col + 4);
            r[0] += w0[0] * LO16(v.x); r[1] += w0[1] * HI16(v.x); r[2] += w0[2] * LO16(v.y); r[3] += w0[3] * HI16(v.y);
            r[4] += w1[0] * LO16(v.z); r[5] += w1[1] * HI16(v.z); r[6] += w1[2] * LO16(v.w); r[7] += w1[3] * HI16(v.w);
        }
    }
#pragma unroll
    for (int e = 0; e < 8; ++e) r[e] = silu_f(r[e]);
}

__device__ __forceinline__ void m1_phase(LAS unsigned char* lds, const bf16_t* U, const float* qkw, const float* GB, const float* GLI, const float* GM, float* GMW, bf16_t* CBUF, float* NBUF, int tid) {
    const int wave = tid >> 6, lane = tid & 63, fr = lane & 15, fq = lane >> 4;
    LAS bf16_t* KT = (LAS bf16_t*)lds;
    LAS bf16_t* VT = KT + 192 * 72;
    for (int item = blockIdx.x; item < 2048; item += gridDim.x) {
        const int bh = item >> 6, c = item & 63, b = bh >> 2, h = bh & 3;
        const size_t tok0 = (size_t)b * SEQ + c * 64;
        __syncthreads();
        {
            const int s = tid & 63, g0 = tid >> 6;
            const size_t gi = (size_t)bh * SEQ + c * 64;
            float mst_c, mnew_c, dec_c; chunk_stab(GM, bh, c, lane, mst_c, mnew_c, dec_c);
            if (tid == 0) { GMW[bh * 64 + c] = mst_c; GMW[2048 + bh * 64 + c] = mnew_c; GMW[4096 + bh * 64 + c] = dec_c; }
            const float wk = __expf(GB[gi + 63] - GB[gi + s] + GLI[gi + s] - mnew_c) * RS192;
#pragma unroll
            for (int it = 0; it < 3; ++it) {
                const int g = g0 + 8 * it, ch = h * 192 + g * 8;
                float kv[8];
                qk_conv8(U, qkw, tok0 + s, c * 64 + s, 768 + ch, kv);
                const u32x4 vv = *(const u32x4*)(U + (tok0 + s) * LDU1 + 1536 + ch);
                LAS bf16_t* kd = KT + (g * 8) * 72 + s; LAS bf16_t* vd = VT + (g * 8) * 72 + s;
#pragma unroll
                for (int e = 0; e < 8; ++e) kd[e * 72] = (bf16_t)f2bf(kv[e] * wk);
                vd[0] = (bf16_t)(vv.x & 0xffffu); vd[72] = (bf16_t)(vv.x >> 16); vd[2 * 72] = (bf16_t)(vv.y & 0xffffu); vd[3 * 72] = (bf16_t)(vv.y >> 16);
                vd[4 * 72] = (bf16_t)(vv.z & 0xffffu); vd[5 * 72] = (bf16_t)(vv.z >> 16); vd[6 * 72] = (bf16_t)(vv.w & 0xffffu); vd[7 * 72] = (bf16_t)(vv.w >> 16);
            }
        }
        __syncthreads();
        if (tid < 192) { float sm = 0.f;
#pragma unroll 8
            for (int s = 0; s < 64; ++s) sm += bf2f(KT[tid * 72 + s]);
            NBUF[(size_t)(bh * 64 + c) * 192 + tid] = sm; }
        bf16_t* cb = CBUF + (size_t)(bh * 64 + c) * 36864;
#pragma unroll 2
        for (int i = 0; i < 18; ++i) {
            const int idx = wave * 18 + i, dkt = idx / 12, dvt = idx % 12;
            const LAS bf16_t* ap = KT + (dkt * 16 + fr) * 72 + fq * 8; const LAS bf16_t* bp = VT + (dvt * 16 + fr) * 72 + fq * 8;
            f32x4 a = {0.f, 0.f, 0.f, 0.f};
            a = MFMA16(*(const LAS bf16x8*)ap, *(const LAS bf16x8*)bp, a);
            a = MFMA16(*(const LAS bf16x8*)(ap + 32), *(const LAS bf16x8*)(bp + 32), a);
            u32x2 w; w.x = pk2(a[0], a[1]); w.y = pk2(a[2], a[3]);
            *(u32x2*)(cb + (size_t)(dvt * 16 + fr) * 192 + dkt * 16 + fq * 4) = w;
        }
    }
}

__device__ __forceinline__ void m2_phase(bf16_t* CBUF, float* NBUF, const float* GM, int tidx) {
    for (int i = (int)blockIdx.x * 288 + tidx; tidx < 288 && i < 32 * 2304; i += (int)gridDim.x * 288) {
        const int bh = i / 2304, e = i % 2304;
        bf16_t* ptr = CBUF + (size_t)bh * 64 * 36864 + e * 16;
        const float* dec = GM + 4096 + bh * 64;
        float r[16];
#pragma unroll
        for (int k = 0; k < 16; ++k) r[k] = 0.f;
        u32x4 cur[4][2], nxt[4][2];
#pragma unroll
        for (int j = 0; j < 4; ++j) { cur[j][0] = *(const u32x4*)(ptr + (size_t)j * 36864); cur[j][1] = *(const u32x4*)(ptr + (size_t)j * 36864 + 8); }
#pragma unroll 1
        for (int cb = 0; cb < 64; cb += 4) {
            bf16_t* pb = ptr + (size_t)cb * 36864;
            if (cb + 4 < 64) {
#pragma unroll
                for (int j = 0; j < 4; ++j) { nxt[j][0] = *(const u32x4*)(pb + (size_t)(4 + j) * 36864); nxt[j][1] = *(const u32x4*)(pb + (size_t)(4 + j) * 36864 + 8); }
            }
#pragma unroll
            for (int j = 0; j < 4; ++j) {
                const u32x4 d0 = cur[j][0], d1 = cur[j][1];
                u32x4 w0, w1;
                w0.x = pk2(r[0], r[1]); w0.y = pk2(r[2], r[3]); w0.z = pk2(r[4], r[5]); w0.w = pk2(r[6], r[7]);
                w1.x = pk2(r[8], r[9]); w1.y = pk2(r[10], r[11]); w1.z = pk2(r[12], r[13]); w1.w = pk2(r[14], r[15]);
                *(u32x4*)(pb + (size_t)j * 36864) = w0; *(u32x4*)(pb + (size_t)j * 36864 + 8) = w1;
                const float dc = dec[cb + j];
                r[0] = dc * r[0] + LO16(d0.x); r[1] = dc * r[1] + HI16(d0.x); r[2] = dc * r[2] + LO16(d0.y); r[3] = dc * r[3] + HI16(d0.y);
                r[4] = dc * r[4] + LO16(d0.z); r[5] = dc * r[5] + HI16(d0.z); r[6] = dc * r[6] + LO16(d0.w); r[7] = dc * r[7] + HI16(d0.w);
                r[8] = dc * r[8] + LO16(d1.x); r[9] = dc * r[9] + HI16(d1.x); r[10] = dc * r[10] + LO16(d1.y); r[11] = dc * r[11] + HI16(d1.y);
                r[12] = dc * r[12] + LO16(d1.z); r[13] = dc * r[13] + HI16(d1.z); r[14] = dc * r[14] + LO16(d1.w); r[15] = dc * r[15] + HI16(d1.w);
            }
#pragma unroll
            for (int j = 0; j < 4; ++j) { cur[j][0] = nxt[j][0]; cur[j][1] = nxt[j][1]; }
        }
    }
    if (tidx >= 288 && tidx < 312) {
        for (int i = (int)blockIdx.x * 24 + (tidx - 288); i < 32 * 192; i += (int)gridDim.x * 24) {
            const int bh = i / 192, e = i % 192;
            float* ptr = NBUF + (size_t)bh * 64 * 192 + e;
            const float* dec = GM + 4096 + bh * 64;
            float r = 0.f;
            for (int c = 0; c < 64; ++c) { const float d = ptr[c * 192]; ptr[c * 192] = r; r = dec[c] * r + d; }
        }
    }
}

__device__ __forceinline__ void m3_phase(LAS unsigned char* lds, const bf16_t* U, const float* qkw, const float* hng, const float* GB, const float* GLI, const float* GM,
                                         const bf16_t* CBUF, const float* NBUF, bf16_t* MIX, int tid) {
    const int wave = tid >> 6, lane = tid & 63, fr = lane & 15, fq = lane >> 4;
    LAS bf16_t* Qs = (LAS bf16_t*)lds;
    LAS bf16_t* Ks = (LAS bf16_t*)(lds + 25600);
    LAS bf16_t* VT = (LAS bf16_t*)(lds + 51200);
    LAS bf16_t* CT = (LAS bf16_t*)(lds + 78848);
    LAS float* Hs = (LAS float*)(lds + 78848);
    LAS float* nS = (LAS float*)(lds + 155648);
    LAS float* bcS = nS + 192; LAS float* liS = bcS + 64; LAS float* mtS = liS + 64; LAS float* winS = mtS + 64; LAS float* qnS = winS + 64; LAS float* denP = qnS + 64;
    LAS bf16_t* Ps = Ks;
    for (int item = blockIdx.x; item < 2048; item += gridDim.x) {
        const int bh = item >> 6, c = item & 63, b = bh >> 2, h = bh & 3;
        const size_t tok0 = (size_t)b * SEQ + c * 64;
        __syncthreads();
#ifdef M3_DUP_STAGE
#pragma unroll 1
        for (int rep_ = 0; rep_ < 2; ++rep_) { if (rep_) { asm volatile("s_waitcnt vmcnt(0)" ::: "memory"); __syncthreads(); }
#else
        {
#endif
        {
            const bf16_t* cb = CBUF + (size_t)(bh * 64 + c) * 36864;
#pragma unroll
            for (int i = 0; i < 9; ++i) { const int P = tid + 512 * i, row = P / 24, slot = P % 24, chk = slot ^ ((row >> 1) & 7);
                __builtin_amdgcn_global_load_lds((const unsigned*)(cb + (size_t)row * 192 + chk * 8), (LAS unsigned*)((LAS unsigned char*)CT + (wave * 64 + 512 * i) * 16), 16, 0, 0); }
        }
        if (tid < 384) {
            const int g = tid % 24, r = tid / 24, ch = h * 192 + g * 8;
#pragma unroll 1
            for (int qk = 0; qk < 2; ++qk) {
                const int col = qk * 768 + ch; const float scl = qk ? RS192 : 1.0f; LAS bf16_t* dst = qk ? Ks : Qs;
                u32x4 rw[7];
#pragma unroll
                for (int i = 0; i < 7; ++i) {
                    const int sp = 4 * r - 3 + i;
                    if (c * 64 + sp >= 0) rw[i] = *(const u32x4*)(U + (size_t)((long)tok0 + sp) * LDU1 + col); else rw[i] = (u32x4){0u, 0u, 0u, 0u};
                }
                f32x4 wv[4][2];
#pragma unroll
                for (int j = 0; j < 4; ++j) { wv[j][0] = *(const f32x4*)(qkw + j * 1536 + col); wv[j][1] = *(const f32x4*)(qkw + j * 1536 + col + 4); }
#pragma unroll
                for (int si = 0; si < 4; ++si) {
                    float v[8];
#pragma unroll
                    for (int e = 0; e < 8; ++e) v[e] = 0.f;
#pragma unroll
                    for (int j = 0; j < 4; ++j) {
                        const u32x4 a = rw[si + j];
                        v[0] += wv[j][0][0] * LO16(a.x); v[1] += wv[j][0][1] * HI16(a.x); v[2] += wv[j][0][2] * LO16(a.y); v[3] += wv[j][0][3] * HI16(a.y);
                        v[4] += wv[j][1][0] * LO16(a.z); v[5] += wv[j][1][1] * HI16(a.z); v[6] += wv[j][1][2] * LO16(a.w); v[7] += wv[j][1][3] * HI16(a.w);
                    }
#pragma unroll
                    for (int e = 0; e < 8; ++e) v[e] = silu_f(v[e]) * scl;
                    u32x4 w; w.x = pk2(v[0], v[1]); w.y = pk2(v[2], v[3]); w.z = pk2(v[4], v[5]); w.w = pk2(v[6], v[7]);
                    *(LAS u32x4*)(dst + (4 * r + si) * 200 + g * 8) = w;
                }
                asm volatile("" ::: "memory");
            }
        }
        {
            const int s = tid & 63, g0 = tid >> 6;
#pragma unroll
            for (int it = 0; it < 3; ++it) {
                const int g = g0 + 8 * it, ch = h * 192 + g * 8;
                const u32x4 vv = *(const u32x4*)(U + (tok0 + s) * LDU1 + 1536 + ch);
                LAS bf16_t* vd = VT + (g * 8) * 72 + s;
                vd[0] = (bf16_t)(vv.x & 0xffffu); vd[72] = (bf16_t)(vv.x >> 16); vd[2 * 72] = (bf16_t)(vv.y & 0xffffu); vd[3 * 72] = (bf16_t)(vv.y >> 16);
                vd[4 * 72] = (bf16_t)(vv.z & 0xffffu); vd[5 * 72] = (bf16_t)(vv.z >> 16); vd[6 * 72] = (bf16_t)(vv.w & 0xffffu); vd[7 * 72] = (bf16_t)(vv.w >> 16);
            }
        }
        {
            if (tid < 192) nS[tid] = NBUF[(size_t)(bh * 64 + c) * 192 + tid];
            if (tid < 64) { bcS[tid] = GB[(size_t)bh * SEQ + c * 64 + tid]; liS[tid] = GLI[(size_t)bh * SEQ + c * 64 + tid]; }
        }
        }
        const float mst = GM[bh * 64 + c];
        asm volatile("s_waitcnt vmcnt(0)" ::: "memory");
        __syncthreads();
        if (wave == 0) {
            const float bc = bcS[lane]; float pm = liS[lane] - bc;
#pragma unroll
            for (int o = 1; o < 64; o <<= 1) { const float t = __shfl_up(pm, o); if (lane >= o) pm = fmaxf(pm, t); }
            const float mt = bc + fmaxf(mst, pm);
            mtS[lane] = mt; winS[lane] = __expf(bc + mst - mt);
        }
        {
            const int t = tid >> 3, part = tid & 7; float sm = 0.f;
#pragma unroll 8
            for (int d = 0; d < 24; ++d) sm += bf2f(Qs[t * 200 + part * 24 + d]) * nS[part * 24 + d];
            sm += __shfl_xor(sm, 1); sm += __shfl_xor(sm, 2); sm += __shfl_xor(sm, 4);
            if (part == 0) qnS[t] = sm;
        }
        f32x4 sacc[2];
#pragma unroll
        for (int i = 0; i < 2; ++i) {
            const int tile = wave * 2 + i, tt = tile >> 2, st = tile & 3;
            const LAS bf16_t* ap = Qs + (tt * 16 + fr) * 200 + fq * 8; const LAS bf16_t* bp = Ks + (st * 16 + fr) * 200 + fq * 8;
            f32x4 a = {0.f, 0.f, 0.f, 0.f};
#pragma unroll
            for (int ks = 0; ks < 6; ++ks) a = MFMA16(*(const LAS bf16x8*)(ap + ks * 32), *(const LAS bf16x8*)(bp + ks * 32), a);
            sacc[i] = a;
        }
        __syncthreads();
#pragma unroll
        for (int i = 0; i < 2; ++i) {
            const int tile = wave * 2 + i, tt = tile >> 2, st = tile & 3, s = st * 16 + fr;
            const float gs = liS[s] - bcS[s];
#pragma unroll
            for (int j = 0; j < 4; ++j) {
                const int t = tt * 16 + fq * 4 + j;
                const float w = (s <= t) ? __expf(bcS[t] + gs - mtS[t]) : 0.f;
                const float scv = sacc[i][j] * w;
                Ps[t * 72 + s] = (bf16_t)f2bf(scv);
                float rs = scv; rs += __shfl_xor(rs, 1); rs += __shfl_xor(rs, 2); rs += __shfl_xor(rs, 4); rs += __shfl_xor(rs, 8);
                if (fr == 0) denP[t * 4 + st] = rs;
            }
        }
        __syncthreads();
        u32x4 ogc[3];
#pragma unroll
        for (int i = 0; i < 3; ++i) { const int id = lane + 64 * i, orow = id / 24, ochk = id % 24;
            ogc[i] = *(const u32x4*)(U + (tok0 + wave * 8 + orow) * LDU1 + 2304 + h * 192 + ochk * 8); }
        const float hg0 = hng[h * 192 + lane], hg1 = hng[h * 192 + lane + 64], hg2 = hng[h * 192 + lane + 128];
        f32x4 hv[6];
        {
            const int tt = wave >> 1, dvt0 = (wave & 1) * 6;
            const LAS bf16_t* pp = Ps + (tt * 16 + fr) * 72 + fq * 8; const LAS bf16_t* qp = Qs + (tt * 16 + fr) * 200 + fq * 8;
            const bf16x8 pa0 = *(const LAS bf16x8*)pp, pa1 = *(const LAS bf16x8*)(pp + 32);
            bf16x8 qa[6];
#pragma unroll
            for (int ks = 0; ks < 6; ++ks) qa[ks] = *(const LAS bf16x8*)(qp + ks * 32);
            float win[4], rden[4];
#pragma unroll
            for (int j = 0; j < 4; ++j) { const int t = tt * 16 + fq * 4 + j; win[j] = winS[t];
                const float den = (denP[t * 4] + denP[t * 4 + 1]) + (denP[t * 4 + 2] + denP[t * 4 + 3]) + win[j] * qnS[t];
                rden[j] = 1.0f / fmaxf(fabsf(den), __expf(-mtS[t])); }
#pragma unroll
            for (int i = 0; i < 6; ++i) {
                const int dvt = dvt0 + i;
                const LAS bf16_t* vp = VT + (dvt * 16 + fr) * 72 + fq * 8; const LAS bf16_t* cp = CT + (dvt * 16 + fr) * 192; const int csw = (fr >> 1) & 7;
                f32x4 ia = {0.f, 0.f, 0.f, 0.f}, ie = {0.f, 0.f, 0.f, 0.f};
                ia = MFMA16(pa0, *(const LAS bf16x8*)vp, ia); ia = MFMA16(pa1, *(const LAS bf16x8*)(vp + 32), ia);
#pragma unroll
                for (int ks = 0; ks < 6; ++ks) ie = MFMA16(qa[ks], *(const LAS bf16x8*)(cp + ((ks * 4 + fq) ^ csw) * 8), ie);
#pragma unroll
                for (int j = 0; j < 4; ++j) hv[i][j] = (ia[j] + win[j] * ie[j]) * rden[j];
            }
        }
        __syncthreads();
        {
            const int tt = wave >> 1, dvt0 = (wave & 1) * 6;
#pragma unroll
            for (int i = 0; i < 6; ++i)
#pragma unroll
                for (int j = 0; j < 4; ++j) Hs[(tt * 16 + fq * 4 + j) * 196 + (dvt0 + i) * 16 + fr] = hv[i][j];
        }
        __syncthreads();
#ifdef M3_DUP_HN
#pragma unroll 1
        for (int rep_ = 0; rep_ < 2; ++rep_)
#endif
        {
            LAS bf16_t* osc = Qs + wave * 1536;
#pragma unroll
            for (int i = 0; i < 3; ++i) { const int id = lane + 64 * i, orow = id / 24, ochk = id % 24; *(LAS u32x4*)(osc + orow * 192 + ochk * 8) = ogc[i]; }
            asm volatile("s_waitcnt lgkmcnt(0)" ::: "memory");
#pragma unroll 1
            for (int rb = 0; rb < 2; ++rb) {
                float x[4][3];
#pragma unroll
                for (int r = 0; r < 4; ++r) { const int t = wave * 8 + rb * 4 + r; x[r][0] = Hs[t * 196 + lane]; x[r][1] = Hs[t * 196 + lane + 64]; x[r][2] = Hs[t * 196 + lane + 128]; }
                float mean[4], var[4];
#pragma unroll
                for (int r = 0; r < 4; ++r) mean[r] = x[r][0] + x[r][1] + x[r][2];
#pragma unroll
                for (int o = 1; o < 64; o <<= 1)
#pragma unroll
                    for (int r = 0; r < 4; ++r) mean[r] += __shfl_xor(mean[r], o);
#pragma unroll
                for (int r = 0; r < 4; ++r) { mean[r] *= (1.f / 192.f); x[r][0] -= mean[r]; x[r][1] -= mean[r]; x[r][2] -= mean[r]; var[r] = x[r][0] * x[r][0] + x[r][1] * x[r][1] + x[r][2] * x[r][2]; }
#pragma unroll
                for (int o = 1; o < 64; o <<= 1)
#pragma unroll
                    for (int r = 0; r < 4; ++r) var[r] += __shfl_xor(var[r], o);
#pragma unroll
                for (int r = 0; r < 4; ++r) { const int rr = rb * 4 + r, t = wave * 8 + rr;
                    const float rstd = 1.0f / sqrtf(var[r] * (1.f / 192.f) + LN_EPS);
                    bf16_t* mp = MIX + (tok0 + t) * DM + h * 192 + lane;
                    mp[0] = (bf16_t)f2bf(sigmoid_f(bf2f(osc[rr * 192 + lane])) * (x[r][0] * rstd * hg0));
                    mp[64] = (bf16_t)f2bf(sigmoid_f(bf2f(osc[rr * 192 + lane + 64])) * (x[r][1] * rstd * hg1));
                    mp[128] = (bf16_t)f2bf(sigmoid_f(bf2f(osc[rr * 192 + lane + 128])) * (x[r][2] * rstd * hg2)); }
            }
        }
    }
}

#define XB_TMO      128
#define XB_XCNT(j)  (256  + 64 * (j))
#define XB_XSUB(j)  (1280 + 64 * (j))
#define XB_XGEN(j)  (2304 + 64 * (j))
#define XB_TOP      3328
#define XB_TOPGEN   3392
#define XCD_BAR_WORDS 3456
#define XB_SPIN_CAP (1u << 18)
__device__ __forceinline__ unsigned xb_ld(unsigned* p)              { return __hip_atomic_load(p, __ATOMIC_RELAXED, __HIP_MEMORY_SCOPE_AGENT); }
__device__ __forceinline__ unsigned xb_add(unsigned* p, unsigned v) { return __hip_atomic_fetch_add(p, v, __ATOMIC_RELAXED, __HIP_MEMORY_SCOPE_AGENT); }
__device__ __forceinline__ unsigned xb_xcc_id() { return (unsigned)__builtin_amdgcn_s_getreg((3 << 11) | 20) & 0xFu; }
#define XB_SPIN(cond, bar) do { unsigned _sp = 0; while (cond) { __builtin_amdgcn_s_sleep(1); \
    if ((++_sp & 255u) == 0u) { if (xb_ld(&(bar)[XB_TMO])) break; if (_sp > XB_SPIN_CAP) { atomicAdd(&(bar)[XB_TMO], 1u); break; } } } } while (0)
__device__ __forceinline__ void xcd_barrier_complete(unsigned* bar, unsigned x, unsigned& nloc, unsigned& nx) {
    const unsigned G = gridDim.x * gridDim.y * gridDim.z;
    unsigned sum, cnt, mine, sp = 0u;
    for (;;) {
        sum = 0u; cnt = 0u; mine = 0u;
#pragma unroll
        for (unsigned j = 0; j < 16; ++j) { const unsigned c = xb_ld(&bar[XB_XCNT(j)]); sum += c; cnt += (c > 0u) ? 1u : 0u; mine = (j == x) ? c : mine; }
        if (sum == G) break;
        __builtin_amdgcn_s_sleep(1);
        if ((++sp & 255u) == 0u) { if (xb_ld(&bar[XB_TMO])) break; if (sp > XB_SPIN_CAP) { atomicAdd(&bar[XB_TMO], 1u); break; } }
    }
    nloc = mine > 0u ? mine : 1u; nx = cnt > 0u ? cnt : 1u;
}
__device__ __forceinline__ void xcd_barrier(unsigned* bar, volatile LAS unsigned* st) {
    asm volatile("s_waitcnt vmcnt(0)" ::: "memory");
    __syncthreads();
    if (threadIdx.x == 0) {
        __builtin_amdgcn_s_waitcnt(0);
        const unsigned x = xb_xcc_id();
        unsigned nloc = st[0], nx = st[1];
        if (nloc == 0u) { xcd_barrier_complete(bar, x, nloc, nx); st[0] = nloc; st[1] = nx; }
        const unsigned old = xb_add(&bar[XB_XSUB(x)], 1u);
        const unsigned gen = old / nloc;
        if (old + 1u == (gen + 1u) * nloc) {
            __builtin_amdgcn_fence(__ATOMIC_RELEASE, "agent");
            asm volatile("s_waitcnt vmcnt(0)" ::: "memory");
            const unsigned og = xb_add(&bar[XB_TOP], 1u);
            const unsigned tg = og / nx;
            if (og + 1u == (tg + 1u) * nx) xb_add(&bar[XB_TOPGEN], 1u);
            else XB_SPIN(xb_ld(&bar[XB_TOPGEN]) == tg, bar);
            __builtin_amdgcn_fence(__ATOMIC_ACQUIRE, "agent");
            xb_add(&bar[XB_XGEN(x)], 1u);
            asm volatile("s_waitcnt vmcnt(0)" ::: "memory");
        } else {
            XB_SPIN(xb_ld(&bar[XB_XGEN(x)]) == gen, bar);
            __builtin_amdgcn_fence(__ATOMIC_ACQUIRE, "agent");
            asm volatile("s_waitcnt vmcnt(0)" ::: "memory");
        }
    }
    __syncthreads();
}

__device__ __forceinline__ int opaque_tid() { int t = threadIdx.x; asm volatile("" : "+v"(t)); return t; }
__global__ void __launch_bounds__(512, 2) fwd_kernel(Params p) {
    extern __shared__ __attribute__((aligned(16))) unsigned char shm[];
    LAS unsigned char* lds = (LAS unsigned char*)shm;
    cg::grid_group grid = cg::this_grid();
#define tid (opaque_tid())
#define wave (__builtin_amdgcn_readfirstlane(opaque_tid() >> 6))
#define lane (opaque_tid() & 63)
#define gw ((int)blockIdx.x * 8 + wave)
#define ngw ((int)gridDim.x * 8)
#define gtid ((size_t)blockIdx.x * 512 + opaque_tid())
#define nthr ((size_t)gridDim.x * 512)
    unsigned char* ws = p.ws;
    bf16_t* XB = (bf16_t*)(ws + OFF_XB); bf16_t* HU = (bf16_t*)(ws + OFF_HU); bf16_t* CBUF = (bf16_t*)(ws + OFF_CBUF);
    bf16_t* MEMB = (bf16_t*)(ws + OFF_MEMB); float* GATES = (float*)(ws + OFF_GATES); float* NBUF = (float*)(ws + OFF_NBUF);
    float* GB = (float*)(ws + OFF_GB); float* GLI = (float*)(ws + OFF_GLI); float* GM = (float*)(ws + OFF_GM);
    float* X = p.out;
    unsigned* bar = (unsigned*)(ws + OFF_BAR);
    volatile LAS unsigned* bst = (volatile LAS unsigned*)(lds + LDS_MAIN);
    if (threadIdx.x == 0) { bst[0] = 0u; bst[1] = 0u; (void)xb_add(&bar[XB_XCNT(xb_xcc_id())], 1u); }
    __syncthreads();
    if (gridDim.x == 0x7fffffffu) grid.sync();
#define GRID_SYNC() xcd_barrier(bar, bst)

#ifndef NO_PRO
#pragma unroll 1
    for (int i = 0; i < EXTRA_SYNC; ++i) GRID_SYNC();
    if (DUP_PRO) { prologue(p, lds, gw, ngw, wave, lane, gtid, nthr); GRID_SYNC(); }
    prologue(p, lds, gw, ngw, wave, lane, gtid, nthr);
#endif
    GRID_SYNC();

#pragma unroll 1
    for (int l = 0; l < 2; ++l) {
#pragma unroll 1
#ifdef DUP_M12
        for (int sti = 0; sti < 14 + (l == 1 ? 2 : 0); ++sti) {
            const int st = (l == 1 && sti > 7) ? sti - 2 : sti;
#else
        for (int sti = 0; sti < 14 + ((DUP_ST >= 0 && (DUP_L < 0 || DUP_L == l)) ? 1 : 0); ++sti) {
            const int st = (DUP_ST >= 0 && (DUP_L < 0 || DUP_L == l) && sti > DUP_ST) ? sti - 1 : sti;
#endif
            if (l == 0 && st >= 6 && st <= 8) continue;
            bf16_t* MEMKV = (bf16_t*)(ws + OFF_MEMKV) + l * 512;
            if (l == 1 && st == 3) continue;
            const int gk = (st == 0 || st == 11) ? 0 : (st == 1 || st == 12) ? 1 : st == 3 ? 2 : st == 4 ? 3 : st == 9 ? 4 : -1;
            if (gk >= 0) {
#ifndef NO_G1
                const int m = l * 2 + (st >= 11 ? 1 : 0);
                pg8::Gemm g; EpiAll E;
                E.O = HU; E.ldc = FF; E.nstore = 0; E.gates = GATES; E.gate_pn = -1; E.res = X; E.resb = nullptr; E.out = X; E.scale = 1.0f;
                if (gk == 0) { g.A = XB; g.Bt = (const bf16_t*)(ws + OFF_WGU + m * SZ_WGU); g.M = NTOK; g.N = 2 * FF; g.K = DM; E.mode = 0; }
                else if (gk == 1) { g.A = HU; g.Bt = (const bf16_t*)(ws + OFF_WD + m * SZ_WD); g.M = NTOK; g.N = DM; g.K = FF; E.mode = 1; E.res = p.x; E.resb = (l == 0 && st == 1) ? (const bf16_t*)nullptr : XB; E.scale = 0.5f; }
                else if (gk == 2) { g.A = MEMB; g.Bt = (const bf16_t*)(ws + OFF_WKV + l * SZ_WKV); g.M = 2048; g.N = 1024; g.K = DM; E.mode = 2; E.O = MEMKV; E.ldc = 1024; E.nstore = 4; }
                else if (gk == 3) { g.A = XB; g.Bt = (const bf16_t*)(ws + (l == 0 ? OFF_WIN0 : OFF_WIN1)); g.M = NTOK; g.N = (l == 0 ? LDU0 : NIN1P); g.K = DM; E.mode = 2; E.ldc = (l == 0 ? LDU0 : LDU1); E.nstore = (l == 0 ? 10 : 13); E.gate_pn = (l == 0 ? -1 : 13); }
                else { g.A = XB; g.Bt = (const bf16_t*)(ws + OFF_WOUT + l * SZ_WOUT); g.M = NTOK; g.N = DM; g.K = DM; E.mode = 1; }
                pg8::StaticOrder S; S.init(g.M, g.N, (int)gridDim.x, (int)blockIdx.x);
                pg8::gemm_phase<EpiAll, pg8::StaticOrder, PG8_ALIGN, PG8_SP2>(lds, g, S, E);
#endif
            } else if (st == 2 || st == 10 || st == 13) {
                const int kind = st == 2 ? 0 : (st == 10 ? 1 : 2);
#ifndef NO_LN
                ln_phase(X, X, XB, p.ln_g + (size_t)(l * 3 + kind) * DM, p.ln_b + (size_t)(l * 3 + kind) * DM, kind == 0 || (l == 1 && kind == 2), !(l == 1 && kind == 2), gw, ngw, lane);
#endif
            } else if (st == 5) {
                if (l == 0) {
#ifndef NO_MIX0
                    conv_phase(HU, p.convw, XB, gtid, nthr);
                    xattn_phase(lds, HU, LDU0, 2304, MEMKV, XB, tid);
#endif
                } else {
#ifndef NO_M0
                    m0_phase(GATES, p.bgates, GB, GLI, GM, gw, ngw, lane);
                    xattn_phase(lds, HU, LDU1, 3072, MEMKV, XB, tid);
#endif
                }
            } else if (st == 6) {
#ifndef NO_M1
                m1_phase(lds, HU, p.qkconvw, GB, GLI, GM, GM, CBUF, NBUF, tid);
#endif
            } else if (st == 7) {
#ifndef NO_M2
                m2_phase(CBUF, NBUF, GM, tid);
#endif
            } else {
#ifndef NO_M3
                m3_phase(lds, HU, p.qkconvw, p.hng, GB, GLI, GM, CBUF, NBUF, XB, tid);
#endif
            }
            if (st != 3 && !(l == 1 && st == 13)) GRID_SYNC();
        }
    }
}

#undef GRID_SYNC
#undef tid
#undef wave
#undef lane
#undef gw
#undef ngw
#undef gtid
#undef nthr
extern "C" void kernel_launch(void* const* d_in, const int* in_sizes, int n_in, void* d_out, int out_size, void* d_ws, size_t ws_size, hipStream_t stream) {
    static int grid_blocks = 0;
    if (grid_blocks == 0) {
        if (n_in != 15 || ws_size < WS_END) { fprintf(stderr, "kernel_launch: unexpected n_in %d or workspace %zu < %zu\n", n_in, ws_size, (size_t)WS_END); grid_blocks = -1; return; }
        int dev = 0, cus = 0, per_cu = 0;
        hipGetDevice(&dev);
        hipDeviceGetAttribute(&cus, hipDeviceAttributeMultiprocessorCount, dev);
        if (hipFuncSetAttribute((const void*)fwd_kernel, hipFuncAttributeMaxDynamicSharedMemorySize, LDS_BYTES) != hipSuccess) fprintf(stderr, "kernel_launch: hipFuncSetAttribute failed\n");
        if (hipOccupancyMaxActiveBlocksPerMultiprocessor(&per_cu, (const void*)fwd_kernel, 512, LDS_BYTES) != hipSuccess || per_cu < 1) { per_cu = 1; (void)hipGetLastError(); }
        grid_blocks = cus * 1;
        (void)per_cu;
    }
    if (grid_blocks < 0) return;
    Params p{};
    p.x = (const float*)d_in[0]; p.mem = (const float*)d_in[1]; p.ln_g = (const float*)d_in[2]; p.ln_b = (const float*)d_in[3];
    p.wg = (const float*)d_in[4]; p.wu = (const float*)d_in[5]; p.wd = (const float*)d_in[6]; p.wkv = (const float*)d_in[7]; p.wout = (const float*)d_in[8];
    p.win0 = (const float*)d_in[9]; p.convw = (const float*)d_in[10]; p.win1 = (const float*)d_in[11]; p.bgates = (const float*)d_in[12];
    p.qkconvw = (const float*)d_in[13]; p.hng = (const float*)d_in[14];
    p.out = (float*)d_out; p.ws = (unsigned char*)d_ws;
    if (hipMemsetAsync((unsigned char*)d_ws + OFF_BAR, 0, (size_t)3456 * 4, stream) != hipSuccess) fprintf(stderr, "kernel_launch: hipMemsetAsync failed\n");
    void* args[] = {&p};
    hipError_t e = hipLaunchCooperativeKernel((const void*)fwd_kernel, dim3(grid_blocks), dim3(512), args, LDS_BYTES, stream);
    if (e != hipSuccess) fprintf(stderr, "kernel_launch: cooperative launch failed: %s (grid %d)\n", hipGetErrorString(e), grid_blocks);
}
```

```cpp
#include <hip/hip_runtime.h>
#include <hip/hip_cooperative_groups.h>
#include <cstdio>
#include <cstdint>
namespace cg = cooperative_groups;
namespace pg8 {
#define PG8_LAS __attribute__((address_space(3)))
typedef unsigned short bf16_t;
typedef short bf16x8 __attribute__((ext_vector_type(8)));
typedef float f32x4 __attribute__((ext_vector_type(4)));
typedef unsigned u32x4 __attribute__((ext_vector_type(4)));
constexpr int BM = 256, BK = 64, HALF = 128, HTB = HALF * BK * 2  , STAGE_BYTES = 8 * HTB, NXCD = 8, WGM = 8;

__host__ __device__ __forceinline__ int lds_byte(int r, int c) { const int st = (r >> 4) * 2 + (c >> 5), rr = r & 15, cc = c & 31, ob = rr * 64 + cc * 2; return st * 1024 + (ob ^ (((ob >> 9) & 1) << 5)); }
__host__ __device__ __forceinline__ void stage_rc(int b, int& R, int& C) { const int st = b / 1024, sb = b % 1024, swz = sb ^ (((sb >> 9) & 1) << 5); R = (st >> 1) * 16 + swz / 64; C = (st & 1) * 32 + (swz % 64) / 2; }
__host__ __device__ __forceinline__ int perm32(int rho) { const int n = rho >> 4, i = rho & 15; return 8 * (i >> 2) + 4 * n + (i & 3); }

struct Unit { int pm, pn; };
struct Gemm { const bf16_t* A; const bf16_t* Bt; int M, N, K; };

struct StaticOrder {
    int nM, nN, nwg, G, c;
    __host__ __device__ void init(int M, int N, int G_, int c_) { nM = M / BM; nN = N / BM; nwg = nM * nN; G = G_; c = c_; }
    __host__ __device__ bool next(int i, Unit& u) const {
        const long L = (long)i * G + c; if (L >= nwg) return false;
        int wgid = (int)L; { const int q = nwg / NXCD, r = nwg % NXCD, xcd = wgid % NXCD, off = wgid / NXCD; wgid = (xcd < r ? xcd * (q + 1) : r * (q + 1) + (xcd - r) * q) + off; }
        const int nig = WGM * nN, gid = wgid / nig, fm = gid * WGM, gsz = (nM - fm) < WGM ? (nM - fm) : WGM;
        u.pm = fm + ((wgid % nig) % gsz); u.pn = (wgid % nig) / gsz; return true;
    }
    __device__ __forceinline__ void a_ready(const Unit&) const {}
    __device__ __forceinline__ void done(const Unit&) const {}
};
__device__ __forceinline__ unsigned cvt_pk_bf16(float lo, float hi) { unsigned r; asm volatile("v_cvt_pk_bf16_f32 %0, %1, %2" : "=v"(r) : "v"(lo), "v"(hi)); return r; }
typedef float f32x2 __attribute__((ext_vector_type(2)));
template <class Epi, class Sched, bool ALIGN_EPI = false, bool SP2 = false>
__device__ __forceinline__ void gemm_phase(PG8_LAS unsigned char* lds, const Gemm g, const Sched& S, const Epi& E) {
    int tid_ = threadIdx.x; asm volatile("" : "+v"(tid_));
    const int tid = tid_, wid = __builtin_amdgcn_readfirstlane(tid >> 6), lane = tid & 63, wr = wid >> 2, wc = wid & 3, fr = lane & 15, fq = lane >> 4;
    const int K = g.K, nt = K / BK;
    unsigned voffA[2], voffB[2];
#pragma unroll
    for (int i = 0; i < 2; ++i) { int R, C; stage_rc(tid * 16 + i * 8192, R, C); const int Rb = Epi::PERM ? ((R & ~31) + perm32(R & 31)) : R;
        voffA[i] = (unsigned)(R * K + C) * 2u; voffB[i] = (unsigned)(Rb * K + C) * 2u; }
    const size_t kstep = (size_t)(BK * 2);
    const size_t hstep = (size_t)HALF * K * 2;
    const size_t tstep = 2 * hstep;
    const unsigned ldsw = (unsigned)wid * 1024u;
    const int aoff = lds_byte(wr * 64 + fr, fq * 8), boff = lds_byte(wc * 32 + fr, fq * 8);
#define PG8_SA(b, h) (((b) * 2 + (h)) * HTB)
#define PG8_SB(b, h) ((4 + (b) * 2 + (h)) * HTB)
#define PG8_STAGE(bufoff, gbase, voff) do { _Pragma("unroll") for (int _i = 0; _i < 2; ++_i) \
        __builtin_amdgcn_global_load_lds((const unsigned*)((const char*)(gbase) + (voff)[_i]), (PG8_LAS unsigned*)(lds + (bufoff) + ldsw + _i * 8192), 16, 0, 0); } while (0)
#define PG8_LDA(dst, b, h) do { _Pragma("unroll") for (int m = 0; m < 4; ++m) _Pragma("unroll") for (int k = 0; k < 2; ++k) dst[m][k] = *(const PG8_LAS bf16x8*)(lds + PG8_SA(b, h) + aoff + m * 2048 + k * 1024); } while (0)
#define PG8_LDB(dst, b, h) do { _Pragma("unroll") for (int n = 0; n < 2; ++n) _Pragma("unroll") for (int k = 0; k < 2; ++k) dst[n][k] = *(const PG8_LAS bf16x8*)(lds + PG8_SB(b, h) + boff + n * 2048 + k * 1024); } while (0)
#define PG8_MMA(ai, bj, At, Bt) do { __builtin_amdgcn_s_setprio(1); _Pragma("unroll") for (int m = 0; m < 4; ++m) _Pragma("unroll") for (int n = 0; n < 2; ++n) _Pragma("unroll") for (int k = 0; k < 2; ++k) \
        acc[ai][bj][m][n] = __builtin_amdgcn_mfma_f32_16x16x32_bf16(Bt[n][k], At[m][k], acc[ai][bj][m][n], 0, 0, 0); __builtin_amdgcn_s_setprio(0); } while (0)
#define PG8_WAIT_V(n) asm volatile("s_waitcnt vmcnt(" #n ")" ::: "memory")
#define PG8_WAIT_L(n) asm volatile("s_waitcnt lgkmcnt(" #n ")" ::: "memory")
#define PG8_BAR __builtin_amdgcn_s_barrier()
#define PG8_SCHED __builtin_amdgcn_sched_barrier(0)
    Unit cur, nxt; int ui = 0;
    if (!S.next(0, cur)) return;
    f32x4 acc[2][2][4][2];
#pragma unroll
    for (int a = 0; a < 2; ++a)
#pragma unroll
        for (int b = 0; b < 2; ++b)
#pragma unroll
            for (int m = 0; m < 4; ++m)
#pragma unroll
                for (int n = 0; n < 2; ++n) acc[a][b][m][n] = (f32x4){0.f, 0.f, 0.f, 0.f};
    bf16x8 At[4][2], B0[2][2], B1[2][2];
    const char* cA = (const char*)g.A + (size_t)cur.pm * tstep; const char* cB = (const char*)g.Bt + (size_t)cur.pn * tstep;
    S.a_ready(cur);
    if constexpr (SP2) {
        PG8_STAGE(PG8_SB(0, 0), cB, voffB); PG8_STAGE(PG8_SB(0, 1), cB + hstep, voffB); PG8_STAGE(PG8_SA(0, 0), cA, voffA); PG8_STAGE(PG8_SA(0, 1), cA + hstep, voffA);
        if (wr == 1) PG8_BAR;
        PG8_WAIT_V(2); PG8_BAR;
        PG8_STAGE(PG8_SB(1, 0), cB + kstep, voffB); PG8_STAGE(PG8_SA(1, 0), cA + kstep, voffA); PG8_STAGE(PG8_SB(1, 1), cB + hstep + kstep, voffB);
        PG8_WAIT_V(6); PG8_BAR;
    } else {
        PG8_STAGE(PG8_SB(0, 0), cB, voffB); PG8_STAGE(PG8_SA(0, 0), cA, voffA); PG8_STAGE(PG8_SB(0, 1), cB + hstep, voffB); PG8_STAGE(PG8_SA(0, 1), cA + hstep, voffA);
        if (wr == 1) PG8_BAR;
        PG8_WAIT_V(4); PG8_BAR;
        PG8_STAGE(PG8_SB(1, 0), cB + kstep, voffB); PG8_STAGE(PG8_SA(1, 0), cA + kstep, voffA); PG8_STAGE(PG8_SB(1, 1), cB + hstep + kstep, voffB);
        PG8_WAIT_V(6); PG8_BAR;
    }
    for (;;) {
        const bool has_next = S.next(ui + 1, nxt);
        const char* nA = has_next ? (const char*)g.A + (size_t)nxt.pm * tstep : cA; const char* nB = has_next ? (const char*)g.Bt + (size_t)nxt.pn * tstep : cB;
        for (int t = 0; t < nt; t += 2) {
            const bool last = (t == nt - 2);
            const char* a1 = cA + (size_t)(t + 1) * kstep;
            const char* a2 = last ? nA : cA + (size_t)(t + 2) * kstep; const char* b2 = last ? nB : cB + (size_t)(t + 2) * kstep;
            const char* a3 = a2 + kstep; const char* b3 = b2 + kstep;
            if (last && has_next) S.a_ready(nxt);
            if constexpr (SP2) {
            PG8_LDB(B0, 0, 0); PG8_LDB(B1, 0, 1); PG8_SCHED; PG8_LDA(At, 0, 0); PG8_STAGE(PG8_SA(1, 1), a1 + hstep, voffA);
            PG8_WAIT_V(8); PG8_WAIT_L(0); PG8_BAR; PG8_MMA(0, 0, At, B0); PG8_MMA(0, 1, At, B1); PG8_BAR; PG8_SCHED;
            PG8_LDA(At, 0, 1); PG8_STAGE(PG8_SB(0, 0), b2, voffB); PG8_STAGE(PG8_SB(0, 1), b2 + hstep, voffB); PG8_STAGE(PG8_SA(0, 0), a2, voffA);
            PG8_WAIT_V(8); PG8_WAIT_L(0); PG8_BAR; PG8_MMA(1, 0, At, B0); PG8_MMA(1, 1, At, B1); PG8_BAR; PG8_SCHED;
            PG8_LDB(B0, 1, 0); PG8_LDB(B1, 1, 1); PG8_SCHED; PG8_LDA(At, 1, 0); PG8_STAGE(PG8_SA(0, 1), a2 + hstep, voffA);
            PG8_WAIT_V(8); PG8_WAIT_L(0); PG8_BAR; PG8_MMA(0, 0, At, B0); PG8_MMA(0, 1, At, B1); PG8_BAR; PG8_SCHED;
            PG8_LDA(At, 1, 1); PG8_STAGE(PG8_SB(1, 0), b3, voffB); PG8_STAGE(PG8_SB(1, 1), b3 + hstep, voffB); PG8_STAGE(PG8_SA(1, 0), a3, voffA);
            PG8_WAIT_V(8); PG8_WAIT_L(0); PG8_BAR; PG8_MMA(1, 0, At, B0); PG8_MMA(1, 1, At, B1); PG8_BAR; PG8_SCHED;
            } else {
            PG8_LDB(B0, 0, 0); PG8_SCHED; PG8_LDA(At, 0, 0); PG8_STAGE(PG8_SA(1, 1), a1 + hstep, voffA);
            PG8_WAIT_L(8); PG8_BAR; PG8_WAIT_L(0); PG8_MMA(0, 0, At, B0); PG8_BAR; PG8_SCHED;
            PG8_LDB(B1, 0, 1); PG8_STAGE(PG8_SB(0, 0), b2, voffB);
            PG8_BAR; PG8_WAIT_L(0); PG8_MMA(0, 1, At, B1); PG8_BAR;
            PG8_LDA(At, 0, 1); PG8_STAGE(PG8_SA(0, 0), a2, voffA);
            PG8_BAR; PG8_WAIT_L(0); PG8_MMA(1, 0, At, B0); PG8_BAR; PG8_SCHED;
            PG8_STAGE(PG8_SB(0, 1), b2 + hstep, voffB);
            PG8_WAIT_V(6); PG8_BAR; PG8_MMA(1, 1, At, B1); PG8_BAR;
            PG8_LDB(B0, 1, 0); PG8_SCHED; PG8_LDA(At, 1, 0); PG8_STAGE(PG8_SA(0, 1), a2 + hstep, voffA);
            PG8_WAIT_L(8); PG8_BAR; PG8_WAIT_L(0); PG8_MMA(0, 0, At, B0); PG8_BAR; PG8_SCHED;
            PG8_LDB(B1, 1, 1); PG8_STAGE(PG8_SB(1, 0), b3, voffB);
            PG8_BAR; PG8_WAIT_L(0); PG8_MMA(0, 1, At, B1); PG8_BAR;
            PG8_LDA(At, 1, 1); PG8_STAGE(PG8_SA(1, 0), a3, voffA);
            PG8_BAR; PG8_WAIT_L(0); PG8_MMA(1, 0, At, B0); PG8_BAR; PG8_SCHED;
            PG8_STAGE(PG8_SB(1, 1), b3 + hstep, voffB);
            PG8_WAIT_V(6); PG8_BAR; PG8_MMA(1, 1, At, B1); PG8_BAR;
            }
        }
        if constexpr (ALIGN_EPI) { if (wr == 0) PG8_BAR; }
        if constexpr (!Epi::AFTER_DRAIN) { E(acc, cur, wr, wc, fr, fq); S.done(cur); }
        if (!has_next) break;
#pragma unroll
        for (int a = 0; a < 2; ++a)
#pragma unroll
            for (int b = 0; b < 2; ++b)
#pragma unroll
                for (int m = 0; m < 4; ++m)
#pragma unroll
                    for (int n = 0; n < 2; ++n) acc[a][b][m][n] = (f32x4){0.f, 0.f, 0.f, 0.f};
        cur = nxt; cA = nA; cB = nB; ++ui;
        if constexpr (ALIGN_EPI) { if (wr == 1) PG8_BAR; }
    }
    PG8_WAIT_V(0);
    if constexpr (!ALIGN_EPI) { if (wr == 0) PG8_BAR; }
    PG8_BAR;
    if constexpr (Epi::AFTER_DRAIN) { E.fused(acc, cur, wr, wc, fr, fq, lds, wid, lane); S.done(cur); }
#undef PG8_SA
#undef PG8_SB
#undef PG8_STAGE
#undef PG8_LDA
#undef PG8_LDB
#undef PG8_MMA
#undef PG8_WAIT_V
#undef PG8_WAIT_L
#undef PG8_BAR
#undef PG8_SCHED
}
}

using pg8::bf16_t; using pg8::bf16x8; using pg8::f32x4; using pg8::u32x4; using pg8::Unit;
#define LAS __attribute__((address_space(3)))
typedef unsigned u32x2 __attribute__((ext_vector_type(2)));

constexpr int NTOK = 32768, DM = 1024, FF = 2816, SEQ = 4096;
constexpr int LDU0 = 2560, LDU1 = 3328, NIN1P = 3584, NS1 = 3336;
constexpr float LN_EPS = 1e-5f, ALPHA = 1.41421356237f, RS192 = 0.07216878364870322f;
constexpr int LDS_MAIN = 158720, LDS_BYTES = LDS_MAIN + 16;
#ifndef PG8_SP2
#define PG8_SP2 true
#endif
#ifndef PG8_ALIGN
#define PG8_ALIGN true
#endif
#ifndef DUP_ST
#define DUP_ST (-1)
#endif
#ifndef DUP_L
#define DUP_L (-1)
#endif
#ifndef EXTRA_SYNC
#define EXTRA_SYNC 0
#endif
#ifndef DUP_PRO
#define DUP_PRO 0
#endif
#ifndef DUP_LN
#define DUP_LN 0
#endif

constexpr size_t SZ_WGU = (size_t)5632 * 1024 * 2, SZ_WD = (size_t)1024 * 2816 * 2, SZ_WKV = (size_t)512 * 1024 * 2, SZ_WOUT = (size_t)1024 * 1024 * 2;
constexpr size_t OFF_WGU = 0;
constexpr size_t OFF_WD = OFF_WGU + 4 * SZ_WGU;
constexpr size_t OFF_WKV = OFF_WD + 4 * SZ_WD;
constexpr size_t OFF_WOUT = OFF_WKV + 2 * SZ_WKV;
constexpr size_t OFF_WIN0 = OFF_WOUT + 2 * SZ_WOUT;
constexpr size_t OFF_WIN1 = OFF_WIN0 + (size_t)2560 * 1024 * 2;
constexpr size_t OFF_XB = OFF_WIN1 + (size_t)NIN1P * 1024 * 2;
constexpr size_t OFF_HU = OFF_XB + (size_t)NTOK * 1024 * 2;
constexpr size_t OFF_CBUF = OFF_HU + (size_t)NTOK * LDU1 * 2;
constexpr size_t OFF_MEMB = OFF_CBUF + (size_t)2048 * 36864 * 2;
constexpr size_t OFF_MEMKV = OFF_MEMB + (size_t)2048 * 1024 * 2;
constexpr size_t OFF_GATES = OFF_MEMKV + (size_t)2 * 2048 * 512 * 2;
constexpr size_t OFF_NBUF = OFF_GATES + (size_t)NTOK * 8 * 4;
constexpr size_t OFF_GB = OFF_NBUF + (size_t)2048 * 192 * 4;
constexpr size_t OFF_GLI = OFF_GB + (size_t)32 * 4096 * 4;
constexpr size_t OFF_GM = OFF_GLI + (size_t)32 * 4096 * 4;
constexpr size_t OFF_BAR = OFF_GM + (size_t)5 * 2048 * 4;
constexpr size_t WS_END = OFF_BAR + (size_t)3456 * 4;

struct Params {
    const float *x, *mem, *ln_g, *ln_b, *wg, *wu, *wd, *wkv, *wout, *win0, *convw, *win1, *bgates, *qkconvw, *hng;
    float* out; unsigned char* ws;
};

__device__ __forceinline__ float bf2f(unsigned b) { return __uint_as_float(b << 16); }
__device__ __forceinline__ unsigned f2bf(float f) { unsigned u = __float_as_uint(f); u += 0x7FFFu + ((u >> 16) & 1u); return u >> 16; }
__device__ __forceinline__ unsigned pk2(float lo, float hi) { return f2bf(lo) | (f2bf(hi) << 16); }
__device__ __forceinline__ float silu_f(float v) { return v * __builtin_amdgcn_rcpf(1.0f + __expf(-v)); }
__device__ __forceinline__ float sigmoid_f(float v) { return __builtin_amdgcn_rcpf(1.0f + __expf(-v)); }
__device__ __forceinline__ float wsum(float v) {
#pragma unroll
    for (int o = 1; o < 64; o <<= 1) v += __shfl_xor(v, o);
    return v;
}
__device__ __forceinline__ float wmax(float v) {
#pragma unroll
    for (int o = 1; o < 64; o <<= 1) v = fmaxf(v, __shfl_xor(v, o));
    return v;
}
#define LO16(w) bf2f((w) & 0xffffu)
#define HI16(w) __uint_as_float((w) & 0xffff0000u)
#define MFMA16(a, b, c) __builtin_amdgcn_mfma_f32_16x16x32_bf16((a), (b), (c), 0, 0, 0)

struct EpiSwiglu {
    static constexpr bool PERM = true, AFTER_DRAIN = false;
    bf16_t* H;
    __device__ __forceinline__ void operator()(const f32x4 (&acc)[2][2][4][2], const Unit& u, int wr, int wc, int fr, int fq) const {
        const int row0 = u.pm * 256 + wr * 64 + fr, col0 = u.pn * 128 + wc * 32 + 8 * fq;
#pragma unroll
        for (int ai = 0; ai < 2; ++ai)
#pragma unroll
            for (int m = 0; m < 4; ++m) {
                bf16_t* rowp = H + (size_t)(row0 + ai * 128 + m * 16) * FF + col0;
                const f32x4 g0 = acc[ai][0][m][0], g1 = acc[ai][0][m][1], u0 = acc[ai][1][m][0], u1 = acc[ai][1][m][1];
                u32x4 w;
                w.x = pg8::cvt_pk_bf16(silu_f(g0[0]) * u0[0], silu_f(g0[1]) * u0[1]);
                w.y = pg8::cvt_pk_bf16(silu_f(g0[2]) * u0[2], silu_f(g0[3]) * u0[3]);
                w.z = pg8::cvt_pk_bf16(silu_f(g1[0]) * u1[0], silu_f(g1[1]) * u1[1]);
                w.w = pg8::cvt_pk_bf16(silu_f(g1[2]) * u1[2], silu_f(g1[3]) * u1[3]);
                *(u32x4*)rowp = w;
            }
    }
};
struct EpiRes {
    static constexpr bool PERM = false, AFTER_DRAIN = false;
    const float* res; float* out; float scale;
    __device__ __forceinline__ void operator()(const f32x4 (&acc)[2][2][4][2], const Unit& u, int wr, int wc, int fr, int fq) const {
        const int row0 = u.pm * 256 + wr * 64 + fr, col0 = u.pn * 256 + wc * 32 + 4 * fq;
#pragma unroll
        for (int ai = 0; ai < 2; ++ai)
#pragma unroll
            for (int m = 0; m < 4; ++m) {
                const size_t off = (size_t)(row0 + ai * 128 + m * 16) * DM + col0;
#pragma unroll
                for (int bj = 0; bj < 2; ++bj)
#pragma unroll
                    for (int n = 0; n < 2; ++n) {
                        const f32x4 r = *(const f32x4*)(res + off + bj * 128 + n * 16);
                        *(f32x4*)(out + off + bj * 128 + n * 16) = r * ALPHA + acc[ai][bj][m][n] * scale;
                    }
                asm volatile("" ::: "memory");
            }
    }
};
struct EpiU {
    static constexpr bool PERM = true, AFTER_DRAIN = false;
    bf16_t* O; int ldc; int nstore; float* gates; int gate_pn;
    __device__ __forceinline__ void operator()(const f32x4 (&acc)[2][2][4][2], const Unit& u, int wr, int wc, int fr, int fq) const {
        const int row0 = u.pm * 256 + wr * 64 + fr;
        if (u.pn < nstore) {
            const int col0 = u.pn * 256 + wc * 32 + 8 * fq;
#pragma unroll
            for (int ai = 0; ai < 2; ++ai)
#pragma unroll
                for (int m = 0; m < 4; ++m) {
                    bf16_t* rowp = O + (size_t)(row0 + ai * 128 + m * 16) * ldc + col0;
#pragma unroll
                    for (int bj = 0; bj < 2; ++bj) {
                        const f32x4 v0 = acc[ai][bj][m][0], v1 = acc[ai][bj][m][1];
                        u32x4 w; w.x = pg8::cvt_pk_bf16(v0[0], v0[1]); w.y = pg8::cvt_pk_bf16(v0[2], v0[3]); w.z = pg8::cvt_pk_bf16(v1[0], v1[1]); w.w = pg8::cvt_pk_bf16(v1[2], v1[3]);
                        *(u32x4*)(rowp + bj * 128) = w;
                    }
                }
        } else if (u.pn == gate_pn) {
            if (wc == 0 && fq == 0) {
#pragma unroll
                for (int ai = 0; ai < 2; ++ai)
#pragma unroll
                    for (int m = 0; m < 4; ++m) {
                        float* gp = gates + (size_t)(row0 + ai * 128 + m * 16) * 8;
                        *(f32x4*)gp = acc[ai][0][m][0]; *(f32x4*)(gp + 4) = acc[ai][0][m][1];
                    }
            }
        }
    }
};

struct EpiAll {
    static constexpr bool PERM = true, AFTER_DRAIN = false;
    int mode; bf16_t* O; int ldc; int nstore; float* gates; int gate_pn; const float* res; const bf16_t* resb; float* out; float scale;
    __device__ __forceinline__ void operator()(const f32x4 (&acc)[2][2][4][2], const Unit& u, int wr, int wc, int fr, int fq) const {
        const int row0 = u.pm * 256 + wr * 64 + fr;
        if (mode == 0) {
            const int col0 = u.pn * 128 + wc * 32 + 8 * fq;
#pragma unroll
            for (int ai = 0; ai < 2; ++ai)
#pragma unroll
                for (int m = 0; m < 4; ++m) {
                    bf16_t* rowp = O + (size_t)(row0 + ai * 128 + m * 16) * FF + col0;
                    const f32x4 g0 = acc[ai][0][m][0], g1 = acc[ai][0][m][1], u0 = acc[ai][1][m][0], u1 = acc[ai][1][m][1];
                    u32x4 w;
                    w.x = pg8::cvt_pk_bf16(silu_f(g0[0]) * u0[0], silu_f(g0[1]) * u0[1]);
                    w.y = pg8::cvt_pk_bf16(silu_f(g0[2]) * u0[2], silu_f(g0[3]) * u0[3]);
                    w.z = pg8::cvt_pk_bf16(silu_f(g1[0]) * u1[0], silu_f(g1[1]) * u1[1]);
                    w.w = pg8::cvt_pk_bf16(silu_f(g1[2]) * u1[2], silu_f(g1[3]) * u1[3]);
                    *(u32x4*)rowp = w;
                }
        } else if (mode == 1) {
            const int col0 = u.pn * 256 + wc * 32 + 8 * fq;
#pragma unroll
            for (int ai = 0; ai < 2; ++ai)
#pragma unroll
                for (int m = 0; m < 4; ++m) {
                    const size_t off = (size_t)(row0 + ai * 128 + m * 16) * DM + col0;
#pragma unroll
                    for (int bj = 0; bj < 2; ++bj) {
                        f32x4 r0, r1;
                        if (resb) { const u32x4 rb = *(const u32x4*)(resb + off + bj * 128); r0 = (f32x4){LO16(rb.x), HI16(rb.x), LO16(rb.y), HI16(rb.y)}; r1 = (f32x4){LO16(rb.z), HI16(rb.z), LO16(rb.w), HI16(rb.w)}; }
                        else { r0 = *(const f32x4*)(res + off + bj * 128); r1 = *(const f32x4*)(res + off + bj * 128 + 4); }
                        *(f32x4*)(out + off + bj * 128) = r0 * ALPHA + acc[ai][bj][m][0] * scale;
                        *(f32x4*)(out + off + bj * 128 + 4) = r1 * ALPHA + acc[ai][bj][m][1] * scale;
                    }
                    if (m == 3 && !resb) asm volatile("" ::: "memory");
                }
        } else {
            if (u.pn < nstore) {
                const int col0 = u.pn * 256 + wc * 32 + 8 * fq;
#pragma unroll
                for (int ai = 0; ai < 2; ++ai)
#pragma unroll
                    for (int m = 0; m < 4; ++m) {
                        bf16_t* rowp = O + (size_t)(row0 + ai * 128 + m * 16) * ldc + col0;
#pragma unroll
                        for (int bj = 0; bj < 2; ++bj) {
                            const f32x4 v0 = acc[ai][bj][m][0], v1 = acc[ai][bj][m][1];
                            u32x4 w; w.x = pg8::cvt_pk_bf16(v0[0], v0[1]); w.y = pg8::cvt_pk_bf16(v0[2], v0[3]); w.z = pg8::cvt_pk_bf16(v1[0], v1[1]); w.w = pg8::cvt_pk_bf16(v1[2], v1[3]);
                            *(u32x4*)(rowp + bj * 128) = w;
                        }
                    }
            } else if (u.pn == gate_pn) {
                if (wc == 0 && fq == 0) {
#pragma unroll
                    for (int ai = 0; ai < 2; ++ai)
#pragma unroll
                        for (int m = 0; m < 4; ++m) {
                            float* gp = gates + (size_t)(row0 + ai * 128 + m * 16) * 8;
                            *(f32x4*)gp = acc[ai][0][m][0]; *(f32x4*)(gp + 4) = acc[ai][0][m][1];
                        }
                }
            }
        }
    }
};

__device__ __forceinline__ void tr_item(const float* colp4, int Ns, bf16_t* WT, int K, int r0, int k0, LAS float* scr, int lane) {
    f32x4 v[8];
#pragma unroll
    for (int i = 0; i < 8; ++i) { const int kk = (lane >> 3) + 8 * i; v[i] = colp4 ? *(const f32x4*)(colp4 + (size_t)(k0 + kk) * Ns) : (f32x4){0.f, 0.f, 0.f, 0.f}; }
#pragma unroll
    for (int i = 0; i < 8; ++i) { const int kk = (lane >> 3) + 8 * i; LAS float* d = scr + kk * 33 + 4 * (lane & 7); d[0] = v[i][0]; d[1] = v[i][1]; d[2] = v[i][2]; d[3] = v[i][3]; }
    asm volatile("s_waitcnt lgkmcnt(0)" ::: "memory");
    const int c = lane & 7;
#pragma unroll
    for (int j = 0; j < 4; ++j) { const int n = (lane >> 3) + 8 * j; const LAS float* s = scr + (8 * c) * 33 + n;
        u32x4 o; o.x = pk2(s[0], s[33]); o.y = pk2(s[2 * 33], s[3 * 33]); o.z = pk2(s[4 * 33], s[5 * 33]); o.w = pk2(s[6 * 33], s[7 * 33]);
        *(u32x4*)(WT + (size_t)(r0 + n) * K + k0 + 8 * c) = o; }
    asm volatile("s_waitcnt lgkmcnt(0)" ::: "memory");
}
__device__ __forceinline__ void cvt_rows(const float* src, bf16_t* dst, size_t n8, size_t gtid, size_t nthr) {
    for (size_t i = gtid; i < n8; i += nthr) { const f32x4 a = *(const f32x4*)(src + i * 8), b = *(const f32x4*)(src + i * 8 + 4);
        u32x4 w; w.x = pk2(a[0], a[1]); w.y = pk2(a[2], a[3]); w.z = pk2(b[0], b[1]); w.w = pk2(b[2], b[3]); *(u32x4*)(dst + i * 8) = w; }
}
__device__ __forceinline__ void prologue(const Params& p, LAS unsigned char* lds, int gw, int ngw, int wave, int lane, size_t gtid, size_t nthr) {
    LAS float* scr = (LAS float*)(lds + wave * 8704);
    unsigned char* ws = p.ws;
    constexpr int I_GU = 176 * 16, I_D = 32 * 44, I_KV = 16 * 16, I_O = 32 * 16, I_0 = 80 * 16, I_1 = 112 * 16;
    constexpr int NITEMS = 4 * I_GU + 4 * I_D + 2 * I_KV + 2 * I_O + I_0 + I_1;
    const int l31 = 4 * (lane & 7);
    for (int it = gw; it < NITEMS; it += ngw) {
        int r = it;
        if (r < 4 * I_GU) { const int m = r / I_GU; r -= m * I_GU; const int kb = r / 176, nb = r % 176, row = nb * 32 + l31, pn = row >> 8, bj = (row >> 7) & 1, j = row & 127;
            tr_item((bj ? p.wu : p.wg) + (size_t)m * 1024 * FF + 128 * pn + j, FF, (bf16_t*)(ws + OFF_WGU + m * SZ_WGU), 1024, nb * 32, kb * 64, scr, lane); continue; }
        r -= 4 * I_GU;
        if (r < 4 * I_D) { const int m = r / I_D; r -= m * I_D; const int kb = r >> 5, nb = r & 31, row = nb * 32 + l31;
            tr_item(p.wd + (size_t)m * FF * 1024 + row, 1024, (bf16_t*)(ws + OFF_WD + m * SZ_WD), FF, nb * 32, kb * 64, scr, lane); continue; }
        r -= 4 * I_D;
        if (r < 2 * I_KV) { const int m = r / I_KV; r -= m * I_KV; const int kb = r >> 4, nb = r & 15, row = nb * 32 + l31;
            tr_item(p.wkv + (size_t)m * 1024 * 512 + row, 512, (bf16_t*)(ws + OFF_WKV + m * SZ_WKV), 1024, nb * 32, kb * 64, scr, lane); continue; }
        r -= 2 * I_KV;
        if (r < 2 * I_O) { const int m = r / I_O; r -= m * I_O; const int kb = r >> 5, nb = r & 31, row = nb * 32 + l31;
            tr_item(p.wout + (size_t)m * 1024 * 1024 + row, 1024, (bf16_t*)(ws + OFF_WOUT + m * SZ_WOUT), 1024, nb * 32, kb * 64, scr, lane); continue; }
        r -= 2 * I_O;
        if (r < I_0) { const int kb = r / 80, nb = r % 80, row = nb * 32 + l31;
            tr_item(p.win0 + row, LDU0, (bf16_t*)(ws + OFF_WIN0), 1024, nb * 32, kb * 64, scr, lane); continue; }
        r -= I_0;
        { const int kb = r / 112, nb = r % 112, row = nb * 32 + l31;
          const int col = row < 3072 ? row : (row < 3328 ? row + 8 : (row < 3336 ? row - 256 : -1));
          tr_item(col >= 0 ? p.win1 + col : (const float*)nullptr, NS1, (bf16_t*)(ws + OFF_WIN1), 1024, nb * 32, kb * 64, scr, lane); }
    }
    cvt_rows(p.x, (bf16_t*)(ws + OFF_XB), (size_t)NTOK * DM / 8, gtid, nthr);
    cvt_rows(p.mem, (bf16_t*)(ws + OFF_MEMB), (size_t)2048 * DM / 8, gtid, nthr);
}

__device__ __forceinline__ void ln_phase(const float* Xin, float* Xout, bf16_t* XB, const float* g, const float* b, bool wf32, bool wbf, int gw, int ngw, int lane) {
    f32x4 gv[4], bv[4];
#pragma unroll
    for (int j = 0; j < 4; ++j) { gv[j] = ((const f32x4*)g)[lane + 64 * j]; bv[j] = ((const f32x4*)b)[lane + 64 * j]; }
    for (int row0 = gw * 4; row0 < NTOK; row0 += ngw * 4) {
        f32x4 v[4][4]; float s[4], s2[4];
#pragma unroll
        for (int r = 0; r < 4; ++r) { const f32x4* xr = (const f32x4*)(Xin + (size_t)(row0 + r) * DM) + lane;
#pragma unroll
            for (int j = 0; j < 4; ++j) v[r][j] = xr[64 * j]; }
#pragma unroll
        for (int r = 0; r < 4; ++r) { s[r] = 0.f;
#pragma unroll
            for (int j = 0; j < 4; ++j) s[r] += (v[r][j][0] + v[r][j][1]) + (v[r][j][2] + v[r][j][3]); }
#pragma unroll
        for (int o = 1; o < 64; o <<= 1)
#pragma unroll
            for (int r = 0; r < 4; ++r) s[r] += __shfl_xor(s[r], o);
#pragma unroll
        for (int r = 0; r < 4; ++r) { const float mean = s[r] * (1.f / DM); s2[r] = 0.f;
#pragma unroll
            for (int j = 0; j < 4; ++j) { v[r][j] = v[r][j] - mean; s2[r] += (v[r][j][0] * v[r][j][0] + v[r][j][1] * v[r][j][1]) + (v[r][j][2] * v[r][j][2] + v[r][j][3] * v[r][j][3]); } }
#pragma unroll
        for (int o = 1; o < 64; o <<= 1)
#pragma unroll
            for (int r = 0; r < 4; ++r) s2[r] += __shfl_xor(s2[r], o);
#pragma unroll
        for (int r = 0; r < 4; ++r) {
            const float rstd = 1.0f / sqrtf(s2[r] * (1.f / DM) + LN_EPS);
            f32x4* xo = (f32x4*)(Xout + (size_t)(row0 + r) * DM) + lane;
            u32x2* bo = (u32x2*)(XB + (size_t)(row0 + r) * DM) + lane;
#pragma unroll
            for (int j = 0; j < 4; ++j) { const f32x4 y = v[r][j] * rstd * gv[j] + bv[j]; if (wf32) xo[64 * j] = y; if (wbf) { u32x2 w; w.x = pk2(y[0], y[1]); w.y = pk2(y[2], y[3]); bo[64 * j] = w; } }
        }
    }
}

__device__ __forceinline__ void conv_phase(const bf16_t* U, const float* cw, bf16_t* MIX, size_t gtid, size_t nthr) {
    for (size_t i = gtid; i < (size_t)NTOK * 96; i += nthr) {
        const int tok = (int)(i / 96), cgi = (int)(i % 96), pos = tok & (SEQ - 1);
        const bf16_t* up = U + (size_t)tok * LDU0 + cgi * 8;
        const u32x4 bg = *(const u32x4*)up;
        float acc[8];
#pragma unroll
        for (int e = 0; e < 8; ++e) acc[e] = 0.f;
#pragma unroll
        for (int j = 0; j < 3; ++j) {
            if (pos - j >= 0) {
                const u32x4 c = *(const u32x4*)(up - (size_t)j * LDU0 + 768), xi = *(const u32x4*)(up - (size_t)j * LDU0 + 1536);
                const f32x4 w0 = *(const f32x4*)(cw + (2 - j) * 768 + cgi * 8), w1 = *(const f32x4*)(cw + (2 - j) * 768 + cgi * 8 + 4);
                acc[0] += w0[0] * LO16(c.x) * LO16(xi.x); acc[1] += w0[1] * HI16(c.x) * HI16(xi.x);
                acc[2] += w0[2] * LO16(c.y) * LO16(xi.y); acc[3] += w0[3] * HI16(c.y) * HI16(xi.y);
                acc[4] += w1[0] * LO16(c.z) * LO16(xi.z); acc[5] += w1[1] * HI16(c.z) * HI16(xi.z);
                acc[6] += w1[2] * LO16(c.w) * LO16(xi.w); acc[7] += w1[3] * HI16(c.w) * HI16(xi.w);
            }
        }
        u32x4 o;
        o.x = pk2(LO16(bg.x) * acc[0], HI16(bg.x) * acc[1]); o.y = pk2(LO16(bg.y) * acc[2], HI16(bg.y) * acc[3]);
        o.z = pk2(LO16(bg.z) * acc[4], HI16(bg.z) * acc[5]); o.w = pk2(LO16(bg.w) * acc[6], HI16(bg.w) * acc[7]);
        *(u32x4*)(MIX + (size_t)tok * DM + cgi * 8) = o;
    }
}

__device__ __forceinline__ void xattn_phase(LAS unsigned char* lds, const bf16_t* U, int ldu, int qoff, const bf16_t* KV, bf16_t* MIX, int tid) {
    const int wave = tid >> 6, lane = tid & 63, fr = lane & 15, fq = lane >> 4;
    LAS bf16_t* Ks = (LAS bf16_t*)lds;
    LAS bf16_t* Vt = Ks + 256 * 72;
    for (int item = blockIdx.x; item < 256; item += gridDim.x) {
        const int b = item >> 5, hd = (item >> 3) & 3, tc = item & 7;
        __syncthreads();
#pragma unroll
        for (int i = 0; i < 4; ++i) {
            const int id = tid + 512 * i, key = id >> 3, dc = id & 7;
            const bf16_t* src = KV + (size_t)(b * 256 + key) * 1024 + hd * 64 + dc * 8;
            const u32x4 kk = *(const u32x4*)src, vv = *(const u32x4*)(src + 256);
            *(LAS u32x4*)(Ks + key * 72 + dc * 8) = kk;
            const int kb = key >> 4, q4 = (key >> 2) & 3, e4 = key & 3, pos = (kb >> 1) * 32 + q4 * 8 + (kb & 1) * 4 + e4;
            LAS bf16_t* vd = Vt + (dc * 8) * 264 + pos;
            vd[0] = (bf16_t)(vv.x & 0xffffu); vd[264] = (bf16_t)(vv.x >> 16); vd[2 * 264] = (bf16_t)(vv.y & 0xffffu); vd[3 * 264] = (bf16_t)(vv.y >> 16);
            vd[4 * 264] = (bf16_t)(vv.z & 0xffffu); vd[5 * 264] = (bf16_t)(vv.z >> 16); vd[6 * 264] = (bf16_t)(vv.w & 0xffffu); vd[7 * 264] = (bf16_t)(vv.w >> 16);
        }
        __syncthreads();
#pragma unroll 1
        for (int tt = 0; tt < 4; ++tt) {
            asm volatile("" ::: "memory");
            const int tok0 = b * SEQ + tc * 512 + (wave * 4 + tt) * 16;
            const bf16_t* qp = U + (size_t)(tok0 + fr) * ldu + qoff + hd * 64 + fq * 8;
            const bf16x8 qf0 = *(const bf16x8*)qp, qf1 = *(const bf16x8*)(qp + 32);
            f32x4 s[16];
#pragma unroll
            for (int kb = 0; kb < 16; ++kb) {
                const LAS bf16_t* kp = Ks + (kb * 16 + fr) * 72 + fq * 8;
                f32x4 a = {0.f, 0.f, 0.f, 0.f};
                a = MFMA16(*(const LAS bf16x8*)kp, qf0, a);
                a = MFMA16(*(const LAS bf16x8*)(kp + 32), qf1, a);
                s[kb] = a;
            }
            float mx = -3.0e38f;
#pragma unroll
            for (int kb = 0; kb < 16; ++kb) mx = fmaxf(mx, fmaxf(fmaxf(s[kb][0], s[kb][1]), fmaxf(s[kb][2], s[kb][3])));
            mx = fmaxf(mx, __shfl_xor(mx, 16)); mx = fmaxf(mx, __shfl_xor(mx, 32));
            const float sc = 0.125f * 1.44269504089f; float sum = 0.f;
#pragma unroll
            for (int kb = 0; kb < 16; ++kb)
#pragma unroll
                for (int j = 0; j < 4; ++j) { const float pe = exp2f((s[kb][j] - mx) * sc); s[kb][j] = pe; sum += pe; }
            sum += __shfl_xor(sum, 16); sum += __shfl_xor(sum, 32);
            const float inv = 1.0f / sum;
            f32x4 o[4];
#pragma unroll
            for (int dn = 0; dn < 4; ++dn) o[dn] = (f32x4){0.f, 0.f, 0.f, 0.f};
#pragma unroll
            for (int ks = 0; ks < 8; ++ks) {
                u32x4 pw; pw.x = pk2(s[2 * ks][0], s[2 * ks][1]); pw.y = pk2(s[2 * ks][2], s[2 * ks][3]); pw.z = pk2(s[2 * ks + 1][0], s[2 * ks + 1][1]); pw.w = pk2(s[2 * ks + 1][2], s[2 * ks + 1][3]);
                const bf16x8 pf = __builtin_bit_cast(bf16x8, pw);
#pragma unroll
                for (int dn = 0; dn < 4; ++dn) o[dn] = MFMA16(*(const LAS bf16x8*)(Vt + (dn * 16 + fr) * 264 + ks * 32 + fq * 8), pf, o[dn]);
            }
            bf16_t* op = MIX + (size_t)(tok0 + fr) * DM + 768 + hd * 64 + fq * 4;
#pragma unroll
            for (int dn = 0; dn < 4; ++dn) { u32x2 w; w.x = pk2(o[dn][0] * inv, o[dn][1] * inv); w.y = pk2(o[dn][2] * inv, o[dn][3] * inv); *(u32x2*)(op + dn * 16) = w; }
        }
    }
}

__device__ __forceinline__ void m0_phase(const float* GATES, const float* bg, float* GB, float* GLI, float* GM, int gw, int ngw, int lane) {
    for (int item = gw; item < 2048; item += ngw) {
        const int bh = item >> 6, c = item & 63, b = bh >> 2, h = bh & 3;
        const size_t tok = (size_t)b * SEQ + c * 64 + lane;
        const float ip = GATES[tok * 8 + h] + bg[h], fp = GATES[tok * 8 + 4 + h] + bg[4 + h];
        const float lf = fminf(fp, 0.f) - log1pf(expf(-fabsf(fp)));
        float bc = lf;
#pragma unroll
        for (int o = 1; o < 64; o <<= 1) { const float t = __shfl_up(bc, o); if (lane >= o) bc += t; }
        const float bl = __shfl(bc, 63);
        const float mxl = wmax(bl - bc + ip);
        GB[(size_t)bh * SEQ + c * 64 + lane] = bc; GLI[(size_t)bh * SEQ + c * 64 + lane] = ip;
        if (lane == 0) { GM[6144 + item] = bl; GM[8192 + item] = mxl; }
    }
}
__device__ __forceinline__ void chunk_stab(const float* GM, int bh, int c, int lane, float& mst_c, float& mnew_c, float& dec_c) {
    const float bl = GM[6144 + bh * 64 + lane], ml = GM[8192 + bh * 64 + lane];
    float B = bl;
#pragma unroll
    for (int o = 1; o < 64; o <<= 1) { const float t = __shfl_up(B, o); if (lane >= o) B += t; }
    float pm = ml - B;
#pragma unroll
    for (int o = 1; o < 64; o <<= 1) { const float t = __shfl_up(pm, o); if (lane >= o) pm = fmaxf(pm, t); }
    const float mnew = B + fmaxf(0.f, pm);
    const float mprev = __shfl_up(mnew, 1);
    const float mst = lane == 0 ? 0.f : mprev;
    const float dec = expf(bl + mst - mnew);
    mst_c = __int_as_float(__builtin_amdgcn_readlane(__float_as_int(mst), c));
    mnew_c = __int_as_float(__builtin_amdgcn_readlane(__float_as_int(mnew), c));
    dec_c = __int_as_float(__builtin_amdgcn_readlane(__float_as_int(dec), c));
}

__device__ __forceinline__ void qk_conv8(const bf16_t* U, const float* qkw, size_t tok, int pos, int col, float (&r)[8]) {
#pragma unroll
    for (int e = 0; e < 8; ++e) r[e] = 0.f;
#pragma unroll
    for (int j = 0; j < 4; ++j) {
        if (pos - j >= 0) {
            const u32x4 v = *(const u32x4*)(U + (tok - j) * LDU1 + col);
            const f32x4 w0 = *(const f32x4*)(qkw + (3 - j) * 1536 + col), w1 = *(const f32x4*)(qkw + (3 - j) * 1536 + col + 4);
            r[0] += w0[0] * LO16(v.x); r[1] += w0[1] * HI16(v.x); r[2] += w0[2] * LO16(v.y); r[3] += w0[3] * HI16(v.y);
            r[4] += w1[0] * LO16(v.z); r[5] += w1[1] * HI16(v.z); r[6] += w1[2] * LO16(v.w); r[7] += w1[3] * HI16(v.w);
        }
    }
#pragma unroll
    for (int e = 0; e < 8; ++e) r[e] = silu_f(r[e]);
}

__device__ __forceinline__ void m1_phase(LAS unsigned char* lds, const bf16_t* U, const float* qkw, const float* GB, const float* GLI, const float* GM, float* GMW, bf16_t* CBUF, float* NBUF, int tid) {
    const int wave = tid >> 6, lane = tid & 63, fr = lane & 15, fq = lane >> 4;
    LAS bf16_t* KT = (LAS bf16_t*)lds;
    LAS bf16_t* VT = KT + 192 * 72;
    for (int item = blockIdx.x; item < 2048; item += gridDim.x) {
        const int bh = item >> 6, c = item & 63, b = bh >> 2, h = bh & 3;
        const size_t tok0 = (size_t)b * SEQ + c * 64;
        __syncthreads();
        {
            const int s = tid & 63, g0 = tid >> 6;
            const size_t gi = (size_t)bh * SEQ + c * 64;
            float mst_c, mnew_c, dec_c; chunk_stab(GM, bh, c, lane, mst_c, mnew_c, dec_c);
            if (tid == 0) { GMW[bh * 64 + c] = mst_c; GMW[2048 + bh * 64 + c] = mnew_c; GMW[4096 + bh * 64 + c] = dec_c; }
            const float wk = __expf(GB[gi + 63] - GB[gi + s] + GLI[gi + s] - mnew_c) * RS192;
#pragma unroll
            for (int it = 0; it < 3; ++it) {
                const int g = g0 + 8 * it, ch = h * 192 + g * 8;
                float kv[8];
                qk_conv8(U, qkw, tok0 + s, c * 64 + s, 768 + ch, kv);
                const u32x4 vv = *(const u32x4*)(U + (tok0 + s) * LDU1 + 1536 + ch);
                LAS bf16_t* kd = KT + (g * 8) * 72 + s; LAS bf16_t* vd = VT + (g * 8) * 72 + s;
#pragma unroll
                for (int e = 0; e < 8; ++e) kd[e * 72] = (bf16_t)f2bf(kv[e] * wk);
                vd[0] = (bf16_t)(vv.x & 0xffffu); vd[72] = (bf16_t)(vv.x >> 16); vd[2 * 72] = (bf16_t)(vv.y & 0xffffu); vd[3 * 72] = (bf16_t)(vv.y >> 16);
                vd[4 * 72] = (bf16_t)(vv.z & 0xffffu); vd[5 * 72] = (bf16_t)(vv.z >> 16); vd[6 * 72] = (bf16_t)(vv.w & 0xffffu); vd[7 * 72] = (bf16_t)(vv.w >> 16);
            }
        }
        __syncthreads();
        if (tid < 192) { float sm = 0.f;
#pragma unroll 8
            for (int s = 0; s < 64; ++s) sm += bf2f(KT[tid * 72 + s]);
            NBUF[(size_t)(bh * 64 + c) * 192 + tid] = sm; }
        bf16_t* cb = CBUF + (size_t)(bh * 64 + c) * 36864;
#pragma unroll 2
        for (int i = 0; i < 18; ++i) {
            const int idx = wave * 18 + i, dkt = idx / 12, dvt = idx % 12;
            const LAS bf16_t* ap = KT + (dkt * 16 + fr) * 72 + fq * 8; const LAS bf16_t* bp = VT + (dvt * 16 + fr) * 72 + fq * 8;
            f32x4 a = {0.f, 0.f, 0.f, 0.f};
            a = MFMA16(*(const LAS bf16x8*)ap, *(const LAS bf16x8*)bp, a);
            a = MFMA16(*(const LAS bf16x8*)(ap + 32), *(const LAS bf16x8*)(bp + 32), a);
            u32x2 w; w.x = pk2(a[0], a[1]); w.y = pk2(a[2], a[3]);
            *(u32x2*)(cb + (size_t)(dvt * 16 + fr) * 192 + dkt * 16 + fq * 4) = w;
        }
    }
}

__device__ __forceinline__ void m2_phase(bf16_t* CBUF, float* NBUF, const float* GM, int tidx) {
    for (int i = (int)blockIdx.x * 288 + tidx; tidx < 288 && i < 32 * 2304; i += (int)gridDim.x * 288) {
        const int bh = i / 2304, e = i % 2304;
        bf16_t* ptr = CBUF + (size_t)bh * 64 * 36864 + e * 16;
        const float* dec = GM + 4096 + bh * 64;
        float r[16];
#pragma unroll
        for (int k = 0; k < 16; ++k) r[k] = 0.f;
        u32x4 cur[4][2], nxt[4][2];
#pragma unroll
        for (int j = 0; j < 4; ++j) { cur[j][0] = *(const u32x4*)(ptr + (size_t)j * 36864); cur[j][1] = *(const u32x4*)(ptr + (size_t)j * 36864 + 8); }
#pragma unroll 1
        for (int cb = 0; cb < 64; cb += 4) {
            bf16_t* pb = ptr + (size_t)cb * 36864;
            if (cb + 4 < 64) {
#pragma unroll
                for (int j = 0; j < 4; ++j) { nxt[j][0] = *(const u32x4*)(pb + (size_t)(4 + j) * 36864); nxt[j][1] = *(const u32x4*)(pb + (size_t)(4 + j) * 36864 + 8); }
            }
#pragma unroll
            for (int j = 0; j < 4; ++j) {
                const u32x4 d0 = cur[j][0], d1 = cur[j][1];
                u32x4 w0, w1;
                w0.x = pk2(r[0], r[1]); w0.y = pk2(r[2], r[3]); w0.z = pk2(r[4], r[5]); w0.w = pk2(r[6], r[7]);
                w1.x = pk2(r[8], r[9]); w1.y = pk2(r[10], r[11]); w1.z = pk2(r[12], r[13]); w1.w = pk2(r[14], r[15]);
                *(u32x4*)(pb + (size_t)j * 36864) = w0; *(u32x4*)(pb + (size_t)j * 36864 + 8) = w1;
                const float dc = dec[cb + j];
                r[0] = dc * r[0] + LO16(d0.x); r[1] = dc * r[1] + HI16(d0.x); r[2] = dc * r[2] + LO16(d0.y); r[3] = dc * r[3] + HI16(d0.y);
                r[4] = dc * r[4] + LO16(d0.z); r[5] = dc * r[5] + HI16(d0.z); r[6] = dc * r[6] + LO16(d0.w); r[7] = dc * r[7] + HI16(d0.w);
                r[8] = dc * r[8] + LO16(d1.x); r[9] = dc * r[9] + HI16(d1.x); r[10] = dc * r[10] + LO16(d1.y); r[11] = dc * r[11] + HI16(d1.y);
                r[12] = dc * r[12] + LO16(d1.z); r[13] = dc * r[13] + HI16(d1.z); r[14] = dc * r[14] + LO16(d1.w); r[15] = dc * r[15] + HI16(d1.w);
            }
#pragma unroll
            for (int j = 0; j < 4; ++j) { cur[j][0] = nxt[j][0]; cur[j][1] = nxt[j][1]; }
        }
    }
    if (tidx >= 288 && tidx < 312) {
        for (int i = (int)blockIdx.x * 24 + (tidx - 288); i < 32 * 192; i += (int)gridDim.x * 24) {
            const int bh = i / 192, e = i % 192;
            float* ptr = NBUF + (size_t)bh * 64 * 192 + e;
            const float* dec = GM + 4096 + bh * 64;
            float r = 0.f;
            for (int c = 0; c < 64; ++c) { const float d = ptr[c * 192]; ptr[c * 192] = r; r = dec[c] * r + d; }
        }
    }
}

__device__ __forceinline__ void m3_phase(LAS unsigned char* lds, const bf16_t* U, const float* qkw, const float* hng, const float* GB, const float* GLI, const float* GM,
                                         const bf16_t* CBUF, const float* NBUF, bf16_t* MIX, int tid) {
    const int wave = tid >> 6, lane = tid & 63, fr = lane & 15, fq = lane >> 4;
    LAS bf16_t* Qs = (LAS bf16_t*)lds;
    LAS bf16_t* Ks = (LAS bf16_t*)(lds + 25600);
    LAS bf16_t* VT = (LAS bf16_t*)(lds + 51200);
    LAS bf16_t* CT = (LAS bf16_t*)(lds + 78848);
    LAS float* Hs = (LAS float*)lds;
    LAS float* nS = (LAS float*)(lds + 155648);
    LAS float* bcS = nS + 192; LAS float* liS = bcS + 64; LAS float* mtS = liS + 64; LAS float* winS = mtS + 64; LAS float* qnS = winS + 64; LAS float* denP = qnS + 64;
    LAS bf16_t* Ps = Ks;
#define M3_DMA_CT(it_) do { const bf16_t* cb_ = CBUF + (size_t)(it_) * 36864; \
        _Pragma("unroll 1") for (int i_ = 0; i_ < 9; ++i_) { const int P_ = tid + 512 * i_, row_ = P_ / 24, slot_ = P_ % 24, chk_ = slot_ ^ ((row_ >> 1) & 7); \
            __builtin_amdgcn_global_load_lds((const unsigned*)(cb_ + (size_t)row_ * 192 + chk_ * 8), (LAS unsigned*)((LAS unsigned char*)CT + (wave * 64 + 512 * i_) * 16), 16, 0, 0); } } while (0)
    if ((int)blockIdx.x < 2048) M3_DMA_CT(blockIdx.x);
    for (int item = blockIdx.x; item < 2048; item += gridDim.x) {
        const int bh = item >> 6, c = item & 63, b = bh >> 2, h = bh & 3;
        const size_t tok0 = (size_t)b * SEQ + c * 64;
        __syncthreads();
#ifdef M3_DUP_STAGE
#pragma unroll 1
        for (int rep_ = 0; rep_ < 2; ++rep_) { if (rep_) { asm volatile("s_waitcnt vmcnt(0)" ::: "memory"); __syncthreads(); }
#else
        {
#endif
        if (tid < 384) {
            const int g = tid % 24, r = tid / 24, ch = h * 192 + g * 8;
#pragma unroll 1
            for (int qk = 0; qk < 2; ++qk) {
                const int col = qk * 768 + ch; const float scl = qk ? RS192 : 1.0f; LAS bf16_t* dst = qk ? Ks : Qs;
                u32x4 rw[7];
#pragma unroll
                for (int i = 0; i < 7; ++i) {
                    const int sp = 4 * r - 3 + i;
                    if (c * 64 + sp >= 0) rw[i] = *(const u32x4*)(U + (size_t)((long)tok0 + sp) * LDU1 + col); else rw[i] = (u32x4){0u, 0u, 0u, 0u};
                }
                f32x4 wv[4][2];
#pragma unroll
                for (int j = 0; j < 4; ++j) { wv[j][0] = *(const f32x4*)(qkw + j * 1536 + col); wv[j][1] = *(const f32x4*)(qkw + j * 1536 + col + 4); }
#pragma unroll
                for (int si = 0; si < 4; ++si) {
                    float v[8];
#pragma unroll
                    for (int e = 0; e < 8; ++e) v[e] = 0.f;
#pragma unroll
                    for (int j = 0; j < 4; ++j) {
                        const u32x4 a = rw[si + j];
                        v[0] += wv[j][0][0] * LO16(a.x); v[1] += wv[j][0][1] * HI16(a.x); v[2] += wv[j][0][2] * LO16(a.y); v[3] += wv[j][0][3] * HI16(a.y);
                        v[4] += wv[j][1][0] * LO16(a.z); v[5] += wv[j][1][1] * HI16(a.z); v[6] += wv[j][1][2] * LO16(a.w); v[7] += wv[j][1][3] * HI16(a.w);
                    }
#pragma unroll
                    for (int e = 0; e < 8; ++e) v[e] = silu_f(v[e]) * scl;
                    u32x4 w; w.x = pk2(v[0], v[1]); w.y = pk2(v[2], v[3]); w.z = pk2(v[4], v[5]); w.w = pk2(v[6], v[7]);
                    *(LAS u32x4*)(dst + (4 * r + si) * 200 + g * 8) = w;
                }
                asm volatile("" ::: "memory");
            }
        }
        {
            const int s = tid & 63, g0 = tid >> 6;
#pragma unroll
            for (int it = 0; it < 3; ++it) {
                const int g = g0 + 8 * it, ch = h * 192 + g * 8;
                const u32x4 vv = *(const u32x4*)(U + (tok0 + s) * LDU1 + 1536 + ch);
                LAS bf16_t* vd = VT + (g * 8) * 72 + s;
                vd[0] = (bf16_t)(vv.x & 0xffffu); vd[72] = (bf16_t)(vv.x >> 16); vd[2 * 72] = (bf16_t)(vv.y & 0xffffu); vd[3 * 72] = (bf16_t)(vv.y >> 16);
                vd[4 * 72] = (bf16_t)(vv.z & 0xffffu); vd[5 * 72] = (bf16_t)(vv.z >> 16); vd[6 * 72] = (bf16_t)(vv.w & 0xffffu); vd[7 * 72] = (bf16_t)(vv.w >> 16);
            }
        }
        {
            if (tid < 192) nS[tid] = NBUF[(size_t)(bh * 64 + c) * 192 + tid];
            if (tid < 64) { bcS[tid] = GB[(size_t)bh * SEQ + c * 64 + tid]; liS[tid] = GLI[(size_t)bh * SEQ + c * 64 + tid]; }
        }
        }
        const float mst = GM[bh * 64 + c];
        asm volatile("s_waitcnt vmcnt(0)" ::: "memory");
        __syncthreads();
        if (wave == 0) {
            const float bc = bcS[lane]; float pm = liS[lane] - bc;
#pragma unroll
            for (int o = 1; o < 64; o <<= 1) { const float t = __shfl_up(pm, o); if (lane >= o) pm = fmaxf(pm, t); }
            const float mt = bc + fmaxf(mst, pm);
            mtS[lane] = mt; winS[lane] = __expf(bc + mst - mt);
        }
        {
            const int t = tid >> 3, part = tid & 7; float sm = 0.f;
#pragma unroll 8
            for (int d = 0; d < 24; ++d) sm += bf2f(Qs[t * 200 + part * 24 + d]) * nS[part * 24 + d];
            sm += __shfl_xor(sm, 1); sm += __shfl_xor(sm, 2); sm += __shfl_xor(sm, 4);
            if (part == 0) qnS[t] = sm;
        }
        f32x4 sacc[2];
#pragma unroll
        for (int i = 0; i < 2; ++i) {
            const int tile = wave * 2 + i, tt = tile >> 2, st = tile & 3;
            const LAS bf16_t* ap = Qs + (tt * 16 + fr) * 200 + fq * 8; const LAS bf16_t* bp = Ks + (st * 16 + fr) * 200 + fq * 8;
            f32x4 a = {0.f, 0.f, 0.f, 0.f};
#pragma unroll
            for (int ks = 0; ks < 6; ++ks) a = MFMA16(*(const LAS bf16x8*)(ap + ks * 32), *(const LAS bf16x8*)(bp + ks * 32), a);
            sacc[i] = a;
        }
        __syncthreads();
#pragma unroll
        for (int i = 0; i < 2; ++i) {
            const int tile = wave * 2 + i, tt = tile >> 2, st = tile & 3, s = st * 16 + fr;
            const float gs = liS[s] - bcS[s];
#pragma unroll
            for (int j = 0; j < 4; ++j) {
                const int t = tt * 16 + fq * 4 + j;
                const float w = (s <= t) ? __expf(bcS[t] + gs - mtS[t]) : 0.f;
                const float scv = sacc[i][j] * w;
                Ps[t * 72 + s] = (bf16_t)f2bf(scv);
                float rs = scv; rs += __shfl_xor(rs, 1); rs += __shfl_xor(rs, 2); rs += __shfl_xor(rs, 4); rs += __shfl_xor(rs, 8);
                if (fr == 0) denP[t * 4 + st] = rs;
            }
        }
        __syncthreads();
        u32x4 ogc[3];
#pragma unroll
        for (int i = 0; i < 3; ++i) { const int id = lane + 64 * i, orow = id / 24, ochk = id % 24;
            ogc[i] = *(const u32x4*)(U + (tok0 + wave * 8 + orow) * LDU1 + 2304 + h * 192 + ochk * 8); }
        const float hg0 = hng[h * 192 + lane], hg1 = hng[h * 192 + lane + 64], hg2 = hng[h * 192 + lane + 128];
        f32x4 hv[6];
        {
            const int tt = wave >> 1, dvt0 = (wave & 1) * 6;
            const LAS bf16_t* pp = Ps + (tt * 16 + fr) * 72 + fq * 8; const LAS bf16_t* qp = Qs + (tt * 16 + fr) * 200 + fq * 8;
            const bf16x8 pa0 = *(const LAS bf16x8*)pp, pa1 = *(const LAS bf16x8*)(pp + 32);
            bf16x8 qa[6];
#pragma unroll
            for (int ks = 0; ks < 6; ++ks) qa[ks] = *(const LAS bf16x8*)(qp + ks * 32);
            float win[4], rden[4];
#pragma unroll
            for (int j = 0; j < 4; ++j) { const int t = tt * 16 + fq * 4 + j; win[j] = winS[t];
                const float den = (denP[t * 4] + denP[t * 4 + 1]) + (denP[t * 4 + 2] + denP[t * 4 + 3]) + win[j] * qnS[t];
                rden[j] = 1.0f / fmaxf(fabsf(den), __expf(-mtS[t])); }
#pragma unroll
            for (int i = 0; i < 6; ++i) {
                const int dvt = dvt0 + i;
                const LAS bf16_t* vp = VT + (dvt * 16 + fr) * 72 + fq * 8; const LAS bf16_t* cp = CT + (dvt * 16 + fr) * 192; const int csw = (fr >> 1) & 7;
                f32x4 ia = {0.f, 0.f, 0.f, 0.f}, ie = {0.f, 0.f, 0.f, 0.f};
                ia = MFMA16(pa0, *(const LAS bf16x8*)vp, ia); ia = MFMA16(pa1, *(const LAS bf16x8*)(vp + 32), ia);
#pragma unroll
                for (int ks = 0; ks < 6; ++ks) ie = MFMA16(qa[ks], *(const LAS bf16x8*)(cp + ((ks * 4 + fq) ^ csw) * 8), ie);
#pragma unroll
                for (int j = 0; j < 4; ++j) hv[i][j] = (ia[j] + win[j] * ie[j]) * rden[j];
            }
        }
        __syncthreads();
        if (item + (int)gridDim.x < 2048) M3_DMA_CT(item + (int)gridDim.x);
        {
            const int tt = wave >> 1, dvt0 = (wave & 1) * 6;
#pragma unroll
            for (int i = 0; i < 6; ++i)
#pragma unroll
                for (int j = 0; j < 4; ++j) Hs[(tt * 16 + fq * 4 + j) * 196 + (dvt0 + i) * 16 + fr] = hv[i][j];
        }
        __syncthreads();
#ifdef M3_DUP_HN
#pragma unroll 1
        for (int rep_ = 0; rep_ < 2; ++rep_)
#endif
        {
            LAS bf16_t* osc = VT + wave * 1536;
#pragma unroll
            for (int i = 0; i < 3; ++i) { const int id = lane + 64 * i, orow = id / 24, ochk = id % 24; *(LAS u32x4*)(osc + orow * 192 + ochk * 8) = ogc[i]; }
            asm volatile("s_waitcnt lgkmcnt(0)" ::: "memory");
#pragma unroll 1
            for (int rb = 0; rb < 2; ++rb) {
                float x[4][3];
#pragma unroll
                for (int r = 0; r < 4; ++r) { const int t = wave * 8 + rb * 4 + r; x[r][0] = Hs[t * 196 + lane]; x[r][1] = Hs[t * 196 + lane + 64]; x[r][2] = Hs[t * 196 + lane + 128]; }
                float mean[4], var[4];
#pragma unroll
                for (int r = 0; r < 4; ++r) mean[r] = x[r][0] + x[r][1] + x[r][2];
#pragma unroll
                for (int o = 1; o < 64; o <<= 1)
#pragma unroll
                    for (int r = 0; r < 4; ++r) mean[r] += __shfl_xor(mean[r], o);
#pragma unroll
                for (int r = 0; r < 4; ++r) { mean[r] *= (1.f / 192.f); x[r][0] -= mean[r]; x[r][1] -= mean[r]; x[r][2] -= mean[r]; var[r] = x[r][0] * x[r][0] + x[r][1] * x[r][1] + x[r][2] * x[r][2]; }
#pragma unroll
                for (int o = 1; o < 64; o <<= 1)
#pragma unroll
                    for (int r = 0; r < 4; ++r) var[r] += __shfl_xor(var[r], o);
#pragma unroll
                for (int r = 0; r < 4; ++r) { const int rr = rb * 4 + r, t = wave * 8 + rr;
                    const float rstd = 1.0f / sqrtf(var[r] * (1.f / 192.f) + LN_EPS);
                    bf16_t* mp = MIX + (tok0 + t) * DM + h * 192 + lane;
                    mp[0] = (bf16_t)f2bf(sigmoid_f(bf2f(osc[rr * 192 + lane])) * (x[r][0] * rstd * hg0));
                    mp[64] = (bf16_t)f2bf(sigmoid_f(bf2f(osc[rr * 192 + lane + 64])) * (x[r][1] * rstd * hg1));
                    mp[128] = (bf16_t)f2bf(sigmoid_f(bf2f(osc[rr * 192 + lane + 128])) * (x[r][2] * rstd * hg2)); }
            }
        }
    }
}

#undef M3_DMA_CT
#define XB_TMO      128
#define XB_XCNT(j)  (256  + 64 * (j))
#define XB_XSUB(j)  (1280 + 64 * (j))
#define XB_XGEN(j)  (2304 + 64 * (j))
#define XB_TOP      3328
#define XB_TOPGEN   3392
#define XCD_BAR_WORDS 3456
#define XB_SPIN_CAP (1u << 18)
__device__ __forceinline__ unsigned xb_ld(unsigned* p)              { return __hip_atomic_load(p, __ATOMIC_RELAXED, __HIP_MEMORY_SCOPE_AGENT); }
__device__ __forceinline__ unsigned xb_add(unsigned* p, unsigned v) { return __hip_atomic_fetch_add(p, v, __ATOMIC_RELAXED, __HIP_MEMORY_SCOPE_AGENT); }
__device__ __forceinline__ unsigned xb_xcc_id() { return (unsigned)__builtin_amdgcn_s_getreg((3 << 11) | 20) & 0xFu; }
#define XB_SPIN(cond, bar) do { unsigned _sp = 0; while (cond) { __builtin_amdgcn_s_sleep(1); \
    if ((++_sp & 255u) == 0u) { if (xb_ld(&(bar)[XB_TMO])) break; if (_sp > XB_SPIN_CAP) { atomicAdd(&(bar)[XB_TMO], 1u); break; } } } } while (0)
__device__ __forceinline__ void xcd_barrier_complete(unsigned* bar, unsigned x, unsigned& nloc, unsigned& nx) {
    const unsigned G = gridDim.x * gridDim.y * gridDim.z;
    unsigned sum, cnt, mine, sp = 0u;
    for (;;) {
        sum = 0u; cnt = 0u; mine = 0u;
#pragma unroll
        for (unsigned j = 0; j < 16; ++j) { const unsigned c = xb_ld(&bar[XB_XCNT(j)]); sum += c; cnt += (c > 0u) ? 1u : 0u; mine = (j == x) ? c : mine; }
        if (sum == G) break;
        __builtin_amdgcn_s_sleep(1);
        if ((++sp & 255u) == 0u) { if (xb_ld(&bar[XB_TMO])) break; if (sp > XB_SPIN_CAP) { atomicAdd(&bar[XB_TMO], 1u); break; } }
    }
    nloc = mine > 0u ? mine : 1u; nx = cnt > 0u ? cnt : 1u;
}
__device__ __forceinline__ void xcd_barrier(unsigned* bar, volatile LAS unsigned* st) {
    asm volatile("s_waitcnt vmcnt(0)" ::: "memory");
    __syncthreads();
    if (threadIdx.x == 0) {
        __builtin_amdgcn_s_waitcnt(0);
        const unsigned x = xb_xcc_id();
        unsigned nloc = st[0], nx = st[1];
        if (nloc == 0u) { xcd_barrier_complete(bar, x, nloc, nx); st[0] = nloc; st[1] = nx; }
        const unsigned old = xb_add(&bar[XB_XSUB(x)], 1u);
        const unsigned gen = old / nloc;
        if (old + 1u == (gen + 1u) * nloc) {
            __builtin_amdgcn_fence(__ATOMIC_RELEASE, "agent");
            asm volatile("s_waitcnt vmcnt(0)" ::: "memory");
            const unsigned og = xb_add(&bar[XB_TOP], 1u);
            const unsigned tg = og / nx;
            if (og + 1u == (tg + 1u) * nx) xb_add(&bar[XB_TOPGEN], 1u);
            else XB_SPIN(xb_ld(&bar[XB_TOPGEN]) == tg, bar);
            __builtin_amdgcn_fence(__ATOMIC_ACQUIRE, "agent");
            xb_add(&bar[XB_XGEN(x)], 1u);
            asm volatile("s_waitcnt vmcnt(0)" ::: "memory");
        } else {
            XB_SPIN(xb_ld(&bar[XB_XGEN(x)]) == gen, bar);
            __builtin_amdgcn_fence(__ATOMIC_ACQUIRE, "agent");
            asm volatile("s_waitcnt vmcnt(0)" ::: "memory");
        }
    }
    __syncthreads();
}

__device__ __forceinline__ int opaque_tid() { int t = threadIdx.x; asm volatile("" : "+v"(t)); return t; }
__global__ void __launch_bounds__(512, 2) fwd_kernel(Params p) {
    extern __shared__ __attribute__((aligned(16))) unsigned char shm[];
    LAS unsigned char* lds = (LAS unsigned char*)shm;
    cg::grid_group grid = cg::this_grid();
#define tid (opaque_tid())
#define wave (__builtin_amdgcn_readfirstlane(opaque_tid() >> 6))
#define lane (opaque_tid() & 63)
#define gw ((int)blockIdx.x * 8 + wave)
#define ngw ((int)gridDim.x * 8)
#define gtid ((size_t)blockIdx.x * 512 + opaque_tid())
#define nthr ((size_t)gridDim.x * 512)
    unsigned char* ws = p.ws;
    bf16_t* XB = (bf16_t*)(ws + OFF_XB); bf16_t* HU = (bf16_t*)(ws + OFF_HU); bf16_t* CBUF = (bf16_t*)(ws + OFF_CBUF);
    bf16_t* MEMB = (bf16_t*)(ws + OFF_MEMB); float* GATES = (float*)(ws + OFF_GATES); float* NBUF = (float*)(ws + OFF_NBUF);
    float* GB = (float*)(ws + OFF_GB); float* GLI = (float*)(ws + OFF_GLI); float* GM = (float*)(ws + OFF_GM);
    float* X = p.out;
    unsigned* bar = (unsigned*)(ws + OFF_BAR);
    volatile LAS unsigned* bst = (volatile LAS unsigned*)(lds + LDS_MAIN);
    if (threadIdx.x == 0) { bst[0] = 0u; bst[1] = 0u; (void)xb_add(&bar[XB_XCNT(xb_xcc_id())], 1u); }
    __syncthreads();
    if (gridDim.x == 0x7fffffffu) grid.sync();
#define GRID_SYNC() xcd_barrier(bar, bst)

#ifndef NO_PRO
#pragma unroll 1
    for (int i = 0; i < EXTRA_SYNC; ++i) GRID_SYNC();
    if (DUP_PRO) { prologue(p, lds, gw, ngw, wave, lane, gtid, nthr); GRID_SYNC(); }
    prologue(p, lds, gw, ngw, wave, lane, gtid, nthr);
#endif
    GRID_SYNC();

#pragma unroll 1
    for (int l = 0; l < 2; ++l) {
#pragma unroll 1
#ifdef DUP_M12
        for (int sti = 0; sti < 14 + (l == 1 ? 2 : 0); ++sti) {
            const int st = (l == 1 && sti > 7) ? sti - 2 : sti;
#else
        for (int sti = 0; sti < 14 + ((DUP_ST >= 0 && (DUP_L < 0 || DUP_L == l)) ? 1 : 0); ++sti) {
            const int st = (DUP_ST >= 0 && (DUP_L < 0 || DUP_L == l) && sti > DUP_ST) ? sti - 1 : sti;
#endif
            if (l == 0 && st >= 6 && st <= 8) continue;
            bf16_t* MEMKV = (bf16_t*)(ws + OFF_MEMKV) + l * 512;
            if (l == 1 && st == 3) continue;
            const int gk = (st == 0 || st == 11) ? 0 : (st == 1 || st == 12) ? 1 : st == 3 ? 2 : st == 4 ? 3 : st == 9 ? 4 : -1;
            if (gk >= 0) {
#ifndef NO_G1
                const int m = l * 2 + (st >= 11 ? 1 : 0);
                pg8::Gemm g; EpiAll E;
                E.O = HU; E.ldc = FF; E.nstore = 0; E.gates = GATES; E.gate_pn = -1; E.res = X; E.resb = nullptr; E.out = X; E.scale = 1.0f;
                if (gk == 0) { g.A = XB; g.Bt = (const bf16_t*)(ws + OFF_WGU + m * SZ_WGU); g.M = NTOK; g.N = 2 * FF; g.K = DM; E.mode = 0; }
                else if (gk == 1) { g.A = HU; g.Bt = (const bf16_t*)(ws + OFF_WD + m * SZ_WD); g.M = NTOK; g.N = DM; g.K = FF; E.mode = 1; E.res = p.x; E.resb = (l == 0 && st == 1) ? (const bf16_t*)nullptr : XB; E.scale = 0.5f; }
                else if (gk == 2) { g.A = MEMB; g.Bt = (const bf16_t*)(ws + OFF_WKV + l * SZ_WKV); g.M = 2048; g.N = 1024; g.K = DM; E.mode = 2; E.O = MEMKV; E.ldc = 1024; E.nstore = 4; }
                else if (gk == 3) { g.A = XB; g.Bt = (const bf16_t*)(ws + (l == 0 ? OFF_WIN0 : OFF_WIN1)); g.M = NTOK; g.N = (l == 0 ? LDU0 : NIN1P); g.K = DM; E.mode = 2; E.ldc = (l == 0 ? LDU0 : LDU1); E.nstore = (l == 0 ? 10 : 13); E.gate_pn = (l == 0 ? -1 : 13); }
                else { g.A = XB; g.Bt = (const bf16_t*)(ws + OFF_WOUT + l * SZ_WOUT); g.M = NTOK; g.N = DM; g.K = DM; E.mode = 1; }
                pg8::StaticOrder S; S.init(g.M, g.N, (int)gridDim.x, (int)blockIdx.x);
                pg8::gemm_phase<EpiAll, pg8::StaticOrder, PG8_ALIGN, PG8_SP2>(lds, g, S, E);
#endif
            } else if (st == 2 || st == 10 || st == 13) {
                const int kind = st == 2 ? 0 : (st == 10 ? 1 : 2);
#ifndef NO_LN
                ln_phase(X, X, XB, p.ln_g + (size_t)(l * 3 + kind) * DM, p.ln_b + (size_t)(l * 3 + kind) * DM, kind == 0 || (l == 1 && kind == 2), !(l == 1 && kind == 2), gw, ngw, lane);
#endif
            } else if (st == 5) {
                if (l == 0) {
#ifndef NO_MIX0
                    conv_phase(HU, p.convw, XB, gtid, nthr);
                    xattn_phase(lds, HU, LDU0, 2304, MEMKV, XB, tid);
#endif
                } else {
#ifndef NO_M0
                    m0_phase(GATES, p.bgates, GB, GLI, GM, gw, ngw, lane);
                    xattn_phase(lds, HU, LDU1, 3072, MEMKV, XB, tid);
#endif
                }
            } else if (st == 6) {
#ifndef NO_M1
                m1_phase(lds, HU, p.qkconvw, GB, GLI, GM, GM, CBUF, NBUF, tid);
#endif
            } else if (st == 7) {
#ifndef NO_M2
                m2_phase(CBUF, NBUF, GM, tid);
#endif
            } else {
#ifndef NO_M3
                m3_phase(lds, HU, p.qkconvw, p.hng, GB, GLI, GM, CBUF, NBUF, XB, tid);
#endif
            }
            if (st != 3 && !(l == 1 && st == 13)) GRID_SYNC();
        }
    }
}

#undef GRID_SYNC
#undef tid
#undef wave
#undef lane
#undef gw
#undef ngw
#undef gtid
#undef nthr
extern "C" void kernel_launch(void* const* d_in, const int* in_sizes, int n_in, void* d_out, int out_size, void* d_ws, size_t ws_size, hipStream_t stream) {
    static int grid_blocks = 0;
    if (grid_blocks == 0) {
        if (n_in != 15 || ws_size < WS_END) { fprintf(stderr, "kernel_launch: unexpected n_in %d or workspace %zu < %zu\n", n_in, ws_size, (size_t)WS_END); grid_blocks = -1; return; }
        int dev = 0, cus = 0, per_cu = 0;
        hipGetDevice(&dev);
        hipDeviceGetAttribute(&cus, hipDeviceAttributeMultiprocessorCount, dev);
        if (hipFuncSetAttribute((const void*)fwd_kernel, hipFuncAttributeMaxDynamicSharedMemorySize, LDS_BYTES) != hipSuccess) fprintf(stderr, "kernel_launch: hipFuncSetAttribute failed\n");
        if (hipOccupancyMaxActiveBlocksPerMultiprocessor(&per_cu, (const void*)fwd_kernel, 512, LDS_BYTES) != hipSuccess || per_cu < 1) { per_cu = 1; (void)hipGetLastError(); }
        grid_blocks = cus * 1;
        (void)per_cu;
    }
    if (grid_blocks < 0) return;
    Params p{};
    p.x = (const float*)d_in[0]; p.mem = (const float*)d_in[1]; p.ln_g = (const float*)d_in[2]; p.ln_b = (const float*)d_in[3];
    p.wg = (const float*)d_in[4]; p.wu = (const float*)d_in[5]; p.wd = (const float*)d_in[6]; p.wkv = (const float*)d_in[7]; p.wout = (const float*)d_in[8];
    p.win0 = (const float*)d_in[9]; p.convw = (const float*)d_in[10]; p.win1 = (const float*)d_in[11]; p.bgates = (const float*)d_in[12];
    p.qkconvw = (const float*)d_in[13]; p.hng = (const float*)d_in[14];
    p.out = (float*)d_out; p.ws = (unsigned char*)d_ws;
    if (hipMemsetAsync((unsigned char*)d_ws + OFF_BAR, 0, (size_t)3456 * 4, stream) != hipSuccess) fprintf(stderr, "kernel_launch: hipMemsetAsync failed\n");
    void* args[] = {&p};
    hipError_t e = hipLaunchCooperativeKernel((const void*)fwd_kernel, dim3(grid_blocks), dim3(512), args, LDS_BYTES, stream);
    if (e != hipSuccess) fprintf(stderr, "kernel_launch: cooperative launch failed: %s (grid %d)\n", hipGetErrorString(e), grid_blocks);
}
```
